# Optimizing an MI355X kernel written in HIP

```python
import math
import jax, jax.numpy as jnp
from jax import lax
import numpy as np

D_MODEL = 1024
BATCH = 2
SEQ = 8192
DEPTH = 1

N_MEM = 256
EPS = 1e-6
MLA_HEADS = 4
QK_NOPE = 128
QK_ROPE = 64
QK_HEAD = QK_NOPE + QK_ROPE
V_HEAD = 128
Q_LORA = 384
KV_LORA = 256
ROPE_THETA = 10000.0
Q_BLOCK = 128
HG_HEADS = 4
HG_DK = 128
HG_DV = 128
HG_CHUNK = 64
MEM_HEADS = 4
MEM_HEAD_DIM = 128
MLA_WIDTH = MLA_HEADS * V_HEAD
HG_KWIDTH = HG_HEADS * HG_DK
HG_WIDTH = HG_HEADS * HG_DV
MEM_WIDTH = MEM_HEADS * MEM_HEAD_DIM
MIX_WIDTH = MLA_WIDTH + HG_WIDTH + MEM_WIDTH
D_FF = -(-8 * D_MODEL // (3 * 256)) * 256
IN_SIZES = (Q_LORA, KV_LORA, QK_ROPE, HG_KWIDTH, HG_KWIDTH, HG_WIDTH, HG_WIDTH, MEM_WIDTH)
IN_WIDTH = Q_LORA + KV_LORA + QK_ROPE + 2 * HG_KWIDTH + 2 * HG_WIDTH + MEM_WIDTH

kernel_name = 'hymba_mla_hgrn2_memxattn_swiglu'


def rmsnorm(x, g):
    xf = x.astype(jnp.float32)
    y = xf * lax.rsqrt(jnp.mean(xf * xf, axis=-1, keepdims=True) + EPS) * g.astype(jnp.float32)
    return y.astype(x.dtype)


def apply_rope(x, pos):
    half = QK_ROPE // 2
    inv_freq = jnp.power(ROPE_THETA, -jnp.arange(half, dtype=jnp.float32) / half)
    ang = pos.astype(jnp.float32)[:, :, None, None] * inv_freq
    cos, sin = jnp.cos(ang), jnp.sin(ang)
    xf = x.astype(jnp.float32)
    x1, x2 = xf[..., :half], xf[..., half:]
    return jnp.concatenate([x1 * cos - x2 * sin, x2 * cos + x1 * sin], axis=-1).astype(x.dtype)


def causal_block_attention(q, k, v):
    B, S, H, Dqk = q.shape
    Dv = v.shape[-1]
    nq = S // Q_BLOCK
    scale = Dqk ** -0.5
    qb = q.astype(jnp.float32).reshape(B, nq, Q_BLOCK, H, Dqk).transpose(1, 0, 2, 3, 4)
    starts = jnp.arange(nq, dtype=jnp.int32) * Q_BLOCK
    kf = k.astype(jnp.float32)
    vf = v.astype(jnp.float32)
    kpos = jnp.arange(S, dtype=jnp.int32)

    def one_block(args):
        qblk, start = args
        s = jnp.einsum('bqhd,bkhd->bhqk', qblk, kf) * scale
        qpos = start + jnp.arange(Q_BLOCK, dtype=jnp.int32)
        mask = kpos[None, :] <= qpos[:, None]
        s = jnp.where(mask[None, None], s, -jnp.inf)
        p = jax.nn.softmax(s, axis=-1)
        return jnp.einsum('bhqk,bkhd->bqhd', p, vf)

    out = lax.map(one_block, (qb, starts))
    return out.transpose(1, 0, 2, 3, 4).reshape(B, S, H, Dv).astype(v.dtype)


def mla_group(c_q, c_kv, k_rope, pos, q_a_norm, w_uq, kv_a_norm, w_ukv, q_norm, k_norm):
    B, S, _ = c_q.shape
    q = (rmsnorm(c_q, q_a_norm) @ w_uq).reshape(B, S, MLA_HEADS, QK_HEAD)
    kv = (rmsnorm(c_kv, kv_a_norm) @ w_ukv).reshape(B, S, MLA_HEADS, QK_NOPE + V_HEAD)
    k_nope, v = kv[..., :QK_NOPE], kv[..., QK_NOPE:]
    k_pe = jnp.broadcast_to(k_rope[:, :, None, :], (B, S, MLA_HEADS, QK_ROPE))
    k = jnp.concatenate([k_nope, k_pe], axis=-1)
    q = rmsnorm(q, q_norm)
    k = rmsnorm(k, k_norm)
    q = jnp.concatenate([q[..., :QK_NOPE], apply_rope(q[..., QK_NOPE:], pos)], axis=-1)
    k = jnp.concatenate([k[..., :QK_NOPE], apply_rope(k[..., QK_NOPE:], pos)], axis=-1)
    o = causal_block_attention(q, k, v)
    return o.reshape(B, S, MLA_WIDTH)


def hgrn2_group(q_raw, f_raw, i_raw, g_raw, lb, out_gain):
    B, S, _ = q_raw.shape
    n = S // HG_CHUNK
    f32 = jnp.float32
    q = jax.nn.silu(q_raw.astype(f32)) * (HG_DK ** -0.5)
    lbf = lb.astype(f32)
    f = lbf + (1.0 - lbf) * jax.nn.sigmoid(f_raw.astype(f32))
    k = 1.0 - f
    logf = jnp.log(f)
    v = i_raw.astype(f32)

    def chunks(t, d):
        return t.reshape(B, n, HG_CHUNK, HG_HEADS, d).transpose(1, 0, 3, 2, 4)

    qc, kc, vc = chunks(q, HG_DK), chunks(k, HG_DK), chunks(v, HG_DV)
    bc = jnp.cumsum(chunks(logf, HG_DK), axis=3)
    causal = jnp.tril(jnp.ones((HG_CHUNK, HG_CHUNK), dtype=bool))

    def chunk_step(state, xs):
        qx, kx, vx, bx = xs
        diff = bx[:, :, :, None, :] - bx[:, :, None, :, :]
        decay = jnp.where(causal[None, None, :, :, None], jnp.exp(jnp.minimum(diff, 0.0)), 0.0)
        a = jnp.einsum('bhtd,bhsd,bhtsd->bhts', qx, kx, decay)
        o = (jnp.einsum('bhts,bhse->bhte', a, vx)
             + jnp.einsum('bhtd,bhde->bhte', qx * jnp.exp(bx), state))
        b_last = bx[:, :, -1:, :]
        new_state = (jnp.exp(b_last[:, :, 0, :])[..., None] * state
                     + jnp.einsum('bhsd,bhse->bhde', kx * jnp.exp(b_last - bx), vx))
        return new_state, o

    s0 = jnp.zeros((B, HG_HEADS, HG_DK, HG_DV), f32)
    _, o = lax.scan(chunk_step, s0, (qc, kc, vc, bc))
    o = o.transpose(1, 0, 3, 2, 4).reshape(B, S, HG_HEADS, HG_DV)
    o = rmsnorm(o, out_gain.reshape(HG_HEADS, HG_DV)).reshape(B, S, HG_WIDTH)
    return (o * jax.nn.silu(g_raw.astype(f32))).astype(q_raw.dtype)


def mem_group(q_raw, mem_h, w_mem_kv, q_norm, k_norm):
    B, S, _ = q_raw.shape
    M = mem_h.shape[1]
    q = rmsnorm(q_raw.reshape(B, S, MEM_HEADS, MEM_HEAD_DIM), q_norm)
    kv = (mem_h @ w_mem_kv).reshape(B, M, 2, MEM_HEADS, MEM_HEAD_DIM)
    k = rmsnorm(kv[:, :, 0], k_norm)
    v = kv[:, :, 1]
    s = jnp.einsum('bqhd,bkhd->bhqk', q.astype(jnp.float32), k.astype(jnp.float32)) * (MEM_HEAD_DIM ** -0.5)
    p = jax.nn.softmax(s, axis=-1)
    o = jnp.einsum('bhqk,bkhd->bqhd', p, v.astype(jnp.float32))
    return o.reshape(B, S, MEM_WIDTH).astype(q_raw.dtype)


def setup_inputs(seed: int = 0) -> dict:
    key = jax.random.key(seed)
    ks = jax.random.split(key, 32)
    f32 = jnp.float32

    def dense(k, shape, fan_in):
        return jax.random.normal(k, shape, f32) * (fan_in ** -0.5)

    def gain(k, shape):
        return 1.0 + 0.05 * jax.random.normal(k, shape, f32)

    L = DEPTH
    x = jax.random.normal(ks[0], (BATCH, SEQ, D_MODEL), f32)
    mem = jax.random.normal(ks[1], (BATCH, N_MEM, D_MODEL), f32)
    offset = jax.random.randint(ks[2], (BATCH, 1), 0, 4096, dtype=jnp.int32)
    positions = offset + jnp.arange(SEQ, dtype=jnp.int32)[None, :]
    return {
        'x': x,
        'mem': mem,
        'positions': positions,
        'norm_mix': gain(ks[3], (L, D_MODEL)),
        'norm_mem': gain(ks[4], (L, D_MODEL)),
        'w_in': dense(ks[5], (L, D_MODEL, IN_WIDTH), D_MODEL),
        'q_a_norm': gain(ks[6], (L, Q_LORA)),
        'w_uq': dense(ks[7], (L, Q_LORA, MLA_HEADS * QK_HEAD), Q_LORA),
        'kv_a_norm': gain(ks[8], (L, KV_LORA)),
        'w_ukv': dense(ks[9], (L, KV_LORA, MLA_HEADS * (QK_NOPE + V_HEAD)), KV_LORA),
        'mla_q_norm': gain(ks[10], (L, QK_HEAD)),
        'mla_k_norm': gain(ks[11], (L, QK_HEAD)),
        'hg_lb_logits': 0.1 * jax.random.normal(ks[12], (L + 1, HG_KWIDTH), f32),
        'hg_out_norm': gain(ks[13], (L, HG_WIDTH)),
        'w_mem_kv': dense(ks[14], (L, D_MODEL, 2 * MEM_WIDTH), D_MODEL),
        'mem_q_norm': gain(ks[15], (L, MEM_HEAD_DIM)),
        'mem_k_norm': gain(ks[16], (L, MEM_HEAD_DIM)),
        'mla_out_norm': gain(ks[17], (L, MLA_WIDTH)),
        'mem_out_norm': gain(ks[18], (L, MEM_WIDTH)),
        'w_out': dense(ks[19], (L, MIX_WIDTH, D_MODEL), MIX_WIDTH),
        'norm_ffn': gain(ks[20], (L, D_MODEL)),
        'w_gate': dense(ks[21], (L, D_MODEL, D_FF), D_MODEL),
        'w_up': dense(ks[22], (L, D_MODEL, D_FF), D_MODEL),
        'w_down': dense(ks[23], (L, D_FF, D_MODEL), D_FF),
    }


def reference(x, mem, positions, norm_mix, norm_mem, w_in, q_a_norm, w_uq, kv_a_norm, w_ukv,
              mla_q_norm, mla_k_norm, hg_lb_logits, hg_out_norm, w_mem_kv, mem_q_norm, mem_k_norm,
              mla_out_norm, mem_out_norm, w_out, norm_ffn, w_gate, w_up, w_down):
    lb_all = jnp.cumsum(jax.nn.softmax(hg_lb_logits.astype(jnp.float32), axis=0), axis=0)
    offsets = [0]
    for sz in IN_SIZES:
        offsets.append(offsets[-1] + sz)
    for l in range(DEPTH):
        h = rmsnorm(x, norm_mix[l])
        mem_h = rmsnorm(mem, norm_mem[l])
        proj = h @ w_in[l]
        c_q, c_kv, k_rope, hq, hf, hi, hg, mq = [proj[..., offsets[j]:offsets[j + 1]] for j in range(len(IN_SIZES))]
        y_mla = mla_group(c_q, c_kv, k_rope, positions, q_a_norm[l], w_uq[l], kv_a_norm[l], w_ukv[l],
                          mla_q_norm[l], mla_k_norm[l])
        y_hg = hgrn2_group(hq, hf, hi, hg, lb_all[l], hg_out_norm[l])
        y_mem = mem_group(mq, mem_h, w_mem_kv[l], mem_q_norm[l], mem_k_norm[l])
        mix = jnp.concatenate([rmsnorm(y_mla, mla_out_norm[l]), y_hg, rmsnorm(y_mem, mem_out_norm[l])], axis=-1)
        x = x + (mix @ w_out[l]).astype(x.dtype)
        h2 = rmsnorm(x, norm_ffn[l])
        x = x + ((jax.nn.silu(h2 @ w_gate[l]) * (h2 @ w_up[l])) @ w_down[l]).astype(x.dtype)
    return x
```

```cpp
#include <hip/hip_runtime.h>
#include <hip/hip_cooperative_groups.h>
#include <stdint.h>
#include <cmath>
#include <cstdio>
namespace cg = cooperative_groups;

#ifndef MEGA
#define MEGA 1
#endif

typedef unsigned short bf16_t;
using bf16x8 = __attribute__((ext_vector_type(8))) short;
using f32x16 = __attribute__((ext_vector_type(16))) float;
#define DI __device__ __forceinline__
#define MFMA(a, b, c) __builtin_amdgcn_mfma_f32_32x32x16_bf16((a), (b), (c), 0, 0, 0)

constexpr int T_TOK = 16384, SEQ = 8192;
constexpr float EPS = 1e-6f;
constexpr float LOG2E = 1.4426950408889634f;

constexpr size_t MiB = 1ull << 20;
constexpr int LD_WIN = 1088, LD_WUQ = 448, LD_WUKV = 320, LD_WMKV = 1088, LD_WOUT = 1600, LD_WGU = 1088, LD_WDN = 2880;
constexpr int LD_XB = 1088, LD_PH = 2112, LD_PM = 576, LD_YMLA = 576, LD_VT = 8256, LD_ACT = 2880;
constexpr size_t OFF_WT_IN = 0;
constexpr size_t OFF_WT_UQ = OFF_WT_IN + 3328ull * LD_WIN * 2;
constexpr size_t OFF_WT_UKV = OFF_WT_UQ + 768ull * LD_WUQ * 2;
constexpr size_t OFF_WT_MKV = OFF_WT_UKV + 1024ull * LD_WUKV * 2;
constexpr size_t OFF_WT_OUT = OFF_WT_MKV + 1024ull * LD_WMKV * 2;
constexpr size_t OFF_WT_GU = OFF_WT_OUT + 1024ull * LD_WOUT * 2;
constexpr size_t OFF_WT_DN = OFF_WT_GU + 5632ull * LD_WGU * 2;
constexpr size_t OFF_WT_END = OFF_WT_DN + 1024ull * LD_WDN * 2;
constexpr size_t OFF_SMALL = 31 * MiB;
static_assert(OFF_WT_END <= OFF_SMALL, "weights overflow");
constexpr size_t OFF_R0 = OFF_SMALL;
constexpr size_t OFF_RM = OFF_R0 + 65536;
constexpr size_t OFF_LB = OFF_RM + 2048;
constexpr size_t OFF_CNT = OFF_LB + 2048;
constexpr size_t OFF_SS = OFF_CNT + 256;
constexpr size_t OFF_COS = OFF_SS + 3 * 65536;
constexpr size_t OFF_SIN = OFF_COS + 2 * MiB;
constexpr size_t OFF_MEMB = OFF_SIN + 2 * MiB;
constexpr size_t OFF_MEMKV = OFF_MEMB + 1 * MiB;
constexpr size_t OFF_KMEM = OFF_MEMKV + 2 * MiB;
constexpr size_t OFF_VMEMT = OFF_KMEM + 512 * 1024;
constexpr size_t OFF_DEC = OFF_VMEMT + 512 * 1024;
constexpr size_t OFF_BAR = OFF_DEC + 512 * 1024;
constexpr size_t OFF_SSL = OFF_BAR + 16384;
constexpr size_t OFF_PROJA = 40 * MiB;
static_assert(OFF_SSL + 2 * 65536 <= OFF_PROJA, "small region overflow (ssl)");
static_assert(OFF_BAR + 16384 <= OFF_PROJA, "small region overflow");
constexpr size_t OFF_YMLA = OFF_PROJA;
constexpr size_t OFF_XB = 62 * MiB;
constexpr size_t OFF_L = OFF_XB;
constexpr size_t OFF_PROJH = 96 * MiB;
constexpr size_t OFF_PROJM = 162 * MiB;
constexpr size_t OFF_Q = 180 * MiB;
constexpr size_t OFF_K = 204 * MiB;
constexpr size_t OFF_VT = 228 * MiB;
constexpr size_t OFF_X1B = OFF_Q;
constexpr size_t OFF_ACT = 40 * MiB;
static_assert(OFF_VT + 1024ull * LD_VT * 2 <= 256 * MiB, "ws overflow");

struct Params {
  const float* x; const float* mem; const int* pos;
  const float *norm_mix, *norm_mem, *w_in, *q_a_norm, *w_uq, *kv_a_norm, *w_ukv, *mla_q_norm, *mla_k_norm, *lb_logits,
      *hg_out_norm, *w_mem_kv, *mem_q_norm, *mem_k_norm, *mla_out_norm, *mem_out_norm, *w_out, *norm_ffn, *w_gate, *w_up, *w_down;
  float* out; char* ws;
  double inv_freq[32];
};

DI float bf2f(bf16_t b) { return __uint_as_float(((unsigned)b) << 16); }
typedef __bf16 bf2_t __attribute__((ext_vector_type(2)));
typedef float f2_t __attribute__((ext_vector_type(2)));
DI unsigned pack2(float a, float b) { f2_t v = {a, b}; return __builtin_bit_cast(unsigned, __builtin_convertvector(v, bf2_t)); }
DI bf16_t f2bf(float x) { return (bf16_t)(pack2(x, 0.f) & 0xffffu); }
DI float lo2f(unsigned u) { return __uint_as_float(u << 16); }
DI float hi2f(unsigned u) { return __uint_as_float(u & 0xffff0000u); }
DI int crow(int reg, int h) { return (reg & 3) + 8 * (reg >> 2) + 4 * h; }
DI float wave_sum(float v) {
  for (int o = 32; o >= 1; o >>= 1) v += __shfl_xor(v, o, 64);
  return v;
}
DI float sigmoidf_(float x) { return __builtin_amdgcn_rcpf(1.f + __expf(-x)); }
DI bf16x8 pack8(const f32x16& x, int s) {
  uint4 p;
  p.x = pack2(x[8 * s + 0], x[8 * s + 1]); p.y = pack2(x[8 * s + 2], x[8 * s + 3]);
  p.z = pack2(x[8 * s + 4], x[8 * s + 5]); p.w = pack2(x[8 * s + 6], x[8 * s + 7]);
  return __builtin_bit_cast(bf16x8, p);
}
DI f32x16 zero16() { f32x16 z; for (int i = 0; i < 16; ++i) z[i] = 0.f; return z; }

constexpr int SMEM_BYTES = 74752;

DI float wgain(const Params& P, int gmode, const float* g1, int k) {
  if (gmode == 0) return 1.f;
  if (gmode == 1) return g1[k];
  return k < 512 ? P.mla_out_norm[k] : (k < 1024 ? 1.f : P.mem_out_norm[k - 1024]);
}
__device__ void transpose_cvt_tile(const Params& P, const float* W, int N, const float* g1, int gmode, bf16_t* Wt, int ldt,
                                   int rowmode, int kt, int nt, char* smem) {
  float(*tile)[65] = (float(*)[65])smem;
  const int tid = threadIdx.x, k0 = kt * 64, n0 = nt * 64;
  for (int i = 0; i < 16; ++i) {
    int idx = tid + 256 * i, kk = idx >> 6, nn = idx & 63;
    float v = 0.f;
    if (n0 + nn < N) v = W[(size_t)(k0 + kk) * N + n0 + nn] * wgain(P, gmode, g1, k0 + kk);
    tile[kk][nn] = v;
  }
  __syncthreads();
  for (int i = 0; i < 16; ++i) {
    int idx = tid + 256 * i, nn = idx >> 6, kk = idx & 63;
    int n = n0 + nn;
    int dr = rowmode == 0 ? n : ((n >> 5) * 64 + (n & 31) + (rowmode == 2 ? 32 : 0));
    Wt[(size_t)dr * ldt + k0 + kk] = f2bf(tile[kk][nn]);
  }
  __syncthreads();
}

__device__ void prep_transpose_job(const Params& P, int j, char* smem) {
  char* ws = P.ws;
  if (j < 832) { transpose_cvt_tile(P, P.w_in, 3264, P.norm_mix, 1, (bf16_t*)(ws + OFF_WT_IN), LD_WIN, 0, j / 52, j % 52, smem); return; }
  j -= 832;
  if (j < 72) { transpose_cvt_tile(P, P.w_uq, 768, P.q_a_norm, 1, (bf16_t*)(ws + OFF_WT_UQ), LD_WUQ, 0, j / 12, j % 12, smem); return; }
  j -= 72;
  if (j < 64) { transpose_cvt_tile(P, P.w_ukv, 1024, P.kv_a_norm, 1, (bf16_t*)(ws + OFF_WT_UKV), LD_WUKV, 0, j / 16, j % 16, smem); return; }
  j -= 64;
  if (j < 256) { transpose_cvt_tile(P, P.w_mem_kv, 1024, P.norm_mem, 1, (bf16_t*)(ws + OFF_WT_MKV), LD_WMKV, 0, j / 16, j % 16, smem); return; }
  j -= 256;
  if (j < 384) { transpose_cvt_tile(P, P.w_out, 1024, nullptr, 2, (bf16_t*)(ws + OFF_WT_OUT), LD_WOUT, 0, j / 16, j % 16, smem); return; }
  j -= 384;
  if (j < 704) { transpose_cvt_tile(P, P.w_gate, 2816, P.norm_ffn, 1, (bf16_t*)(ws + OFF_WT_GU), LD_WGU, 1, j / 44, j % 44, smem); return; }
  j -= 704;
  if (j < 704) { transpose_cvt_tile(P, P.w_up, 2816, P.norm_ffn, 1, (bf16_t*)(ws + OFF_WT_GU), LD_WGU, 2, j / 44, j % 44, smem); return; }
  j -= 704;
  transpose_cvt_tile(P, P.w_down, 1024, nullptr, 0, (bf16_t*)(ws + OFF_WT_DN), LD_WDN, 0, j / 16, j % 16, smem);
}

__device__ void phase0(const Params& P, int bid, int nb, char* smem) {
  char* ws = P.ws;
  const int tid = threadIdx.x, lane = tid & 63, wave = tid >> 6;
  constexpr int J_TR = 1224, J_ROWS = 4224, J_TAB = 2048, J_ZERO = 320, J_LB = 2;
  constexpr int J_TOTAL = J_TR + J_ROWS + J_TAB + J_ZERO + J_LB;
  for (int job = bid; job < J_TOTAL; job += nb) {
    if (job < J_TR) { prep_transpose_job(P, job, smem); continue; }
    int j = job - J_TR;
    if (j < J_ROWS) {
      int row = j * 4 + wave;
      const float* src; bf16_t* dst; float* rdst;
      if (row < T_TOK) { src = P.x + (size_t)row * 1024; dst = (bf16_t*)(ws + OFF_XB) + (size_t)row * LD_XB; rdst = (float*)(ws + OFF_R0) + row; }
      else { int r2 = row - T_TOK; src = P.mem + (size_t)r2 * 1024; dst = (bf16_t*)(ws + OFF_MEMB) + (size_t)r2 * 1024; rdst = (float*)(ws + OFF_RM) + r2; }
      float ss = 0.f;
      float4 v[4];
      for (int i = 0; i < 4; ++i) { v[i] = *(const float4*)(src + (i * 64 + lane) * 4); ss += v[i].x * v[i].x + v[i].y * v[i].y + v[i].z * v[i].z + v[i].w * v[i].w; }
      ss = wave_sum(ss);
      for (int i = 0; i < 4; ++i) { uint2 o; o.x = pack2(v[i].x, v[i].y); o.y = pack2(v[i].z, v[i].w); *(uint2*)(dst + (i * 64 + lane) * 4) = o; }
      if (lane == 0) *rdst = rsqrtf(ss * (1.f / 1024.f) + EPS);
      continue;
    }
    j -= J_ROWS;
    if (j < J_TAB) {
      int idx = j * 256 + tid;
      int t = idx >> 5, i = idx & 31;
      double ang = (double)P.pos[t] * P.inv_freq[i];
      double rev = ang * 0.15915494309189535;
      double fr = rev - rint(rev);
      float f = (float)fr;
      ((float*)(ws + OFF_COS))[idx] = __builtin_amdgcn_cosf(f);
      ((float*)(ws + OFF_SIN))[idx] = __builtin_amdgcn_sinf(f);
      continue;
    }
    j -= J_TAB;
    if (j < J_ZERO) { if (j < 192) ((float*)(ws + OFF_SS))[j * 256 + tid] = 0.f; else ((float*)(ws + OFF_SSL))[(j - 192) * 256 + tid] = 0.f; continue; }
    j -= J_ZERO;
    {
      int c = j * 256 + tid;
      float l0 = P.lb_logits[c], l1 = P.lb_logits[512 + c];
      ((float*)(ws + OFF_LB))[c] = 1.f / (1.f + __expf(l1 - l0));
      if (c < 4) ((unsigned*)(ws + OFF_CNT))[c] = 0u;
    }
  }
}

enum { EPI_PROJ = 0, EPI_MEMKV, EPI_Q, EPI_KV, EPI_OUT, EPI_GU, EPI_DOWN };
constexpr int G_ROWB = 144;
constexpr int G_ATILE = 256 * G_ROWB;
constexpr int G_STAGE = 384 * G_ROWB;
constexpr int LDS_RS = G_STAGE;
constexpr int CW_LD = 68;
constexpr int CW_BYTES = 32 * CW_LD * 4;

struct GArgs {
  const bf16_t *A0, *A1, *A2; int lda0, lda1, lda2; int kb0, kb1, kb2;
  int segIters, nIter, Ktot;
  const bf16_t* Bt; int ldb;
};

template <int EPI>
__device__ __forceinline__ void gemm_tile(const Params& P, const GArgs& g, int m0, int n0, char* smem) {
  const int tid = threadIdx.x, lane = tid & 63, wave = tid >> 6, r = lane & 31, h = lane >> 5;
  const int wm = wave >> 1, wn = wave & 1;
  char* ws = P.ws;
  float* rs = (float*)(smem + LDS_RS);
  float* f3 = rs + 256;

  if (EPI == EPI_Q || EPI == EPI_KV) {
    const float ssv = ((const float*)(ws + OFF_SSL))[(EPI == EPI_KV ? T_TOK : 0) + m0 + tid];
    rs[tid] = rsqrtf(ssv / (float)g.Ktot + EPS);
  }
  if (EPI == EPI_PROJ) rs[tid] = ((const float*)(ws + OFF_R0))[m0 + tid];
  if (EPI == EPI_MEMKV) rs[tid] = ((const float*)(ws + OFF_RM))[m0 + tid];
  if (EPI == EPI_GU) rs[tid] = rsqrtf(((const float*)(ws + OFF_SS))[2 * T_TOK + m0 + tid] * (1.f / 1024.f) + EPS);
  if (EPI == EPI_OUT) {
    const float* ssb = (const float*)(ws + OFF_SS);
    float r1 = rsqrtf(ssb[m0 + tid] * (1.f / 512.f) + EPS);
    float r3 = rsqrtf(ssb[T_TOK + m0 + tid] * (1.f / 512.f) + EPS);
    rs[tid] = r1 / r3; f3[tid] = r3;
  }

  f32x16 acc[4][2];
#pragma unroll
  for (int i = 0; i < 4; ++i) { acc[i][0] = zero16(); acc[i][1] = zero16(); }

  typedef unsigned u32x4_t __attribute__((ext_vector_type(4)));
  u32x4_t ra0, ra1, ra2, ra3, ra4, ra5, ra6, ra7, rb0, rb1, rb2, rb3;
  const bf16_t* const gA0 = g.A0; const bf16_t* const gA1 = g.A1; const bf16_t* const gA2 = g.A2;
  const int glda0 = g.lda0, glda1 = g.lda1, glda2 = g.lda2, gkb0 = g.kb0, gkb1 = g.kb1, gkb2 = g.kb2;
  const int segIters = g.segIters, nIter = g.nIter, ldb = g.ldb;
  const bf16_t* const gBt = g.Bt;
  const int lrow = tid >> 3, lkc = tid & 7;
#define GM_GLD(dst, voff, sbase) asm volatile("global_load_dwordx4 %0, %1, %2" : "=v"(dst) : "v"(voff), "s"(sbase) : "memory")
#define GM_LOADG(it_)                                                                   \
  {                                                                                     \
    const int seg_ = ((it_) >= segIters) + ((it_) >= 2 * segIters);                     \
    const int kk_ = ((it_) - seg_ * segIters) * 64;                                     \
    const bf16_t* Ap_ = gA0; int lda_ = glda0, kb_ = gkb0;                              \
    if (seg_ == 1) { Ap_ = gA1; lda_ = glda1; kb_ = gkb1; }                             \
    if (seg_ == 2) { Ap_ = gA2; lda_ = glda2; kb_ = gkb2; }                             \
    const bf16_t* ab_ = Ap_ + (size_t)m0 * lda_ + kk_;                                  \
    const bf16_t* bb_ = gBt + (size_t)n0 * ldb + kb_ + kk_;                             \
    const unsigned oa_ = (unsigned)(lrow * lda_ + lkc * 8) * 2u, sa2_ = (unsigned)lda_ * 64u; \
    const unsigned ob_ = (unsigned)(lrow * ldb + lkc * 8) * 2u, sb2_ = (unsigned)ldb * 64u;   \
    GM_GLD(ra0, oa_, ab_); GM_GLD(ra1, oa_ + sa2_, ab_); GM_GLD(ra2, oa_ + 2u * sa2_, ab_); GM_GLD(ra3, oa_ + 3u * sa2_, ab_); \
    GM_GLD(ra4, oa_ + 4u * sa2_, ab_); GM_GLD(ra5, oa_ + 5u * sa2_, ab_); GM_GLD(ra6, oa_ + 6u * sa2_, ab_); GM_GLD(ra7, oa_ + 7u * sa2_, ab_); \
    GM_GLD(rb0, ob_, bb_); GM_GLD(rb1, ob_ + sb2_, bb_); GM_GLD(rb2, ob_ + 2u * sb2_, bb_); GM_GLD(rb3, ob_ + 3u * sb2_, bb_); \
  }
#define GM_WAIT0()                                                                      \
  asm volatile("s_waitcnt vmcnt(0)"                                                     \
               : "+v"(ra0), "+v"(ra1), "+v"(ra2), "+v"(ra3), "+v"(ra4), "+v"(ra5), "+v"(ra6), "+v"(ra7),     \
                 "+v"(rb0), "+v"(rb1), "+v"(rb2), "+v"(rb3) : : "memory")
#define GM_STOREL()                                                                     \
  {                                                                                     \
    char* sa_ = smem + lrow * G_ROWB + lkc * 16;                                        \
    char* sb_ = sa_ + G_ATILE;                                                          \
    *(u32x4_t*)(sa_) = ra0; *(u32x4_t*)(sa_ + 32 * G_ROWB) = ra1;                       \
    *(u32x4_t*)(sa_ + 64 * G_ROWB) = ra2; *(u32x4_t*)(sa_ + 96 * G_ROWB) = ra3;         \
    *(u32x4_t*)(sa_ + 128 * G_ROWB) = ra4; *(u32x4_t*)(sa_ + 160 * G_ROWB) = ra5;       \
    *(u32x4_t*)(sa_ + 192 * G_ROWB) = ra6; *(u32x4_t*)(sa_ + 224 * G_ROWB) = ra7;       \
    *(u32x4_t*)(sb_) = rb0; *(u32x4_t*)(sb_ + 32 * G_ROWB) = rb1;                       \
    *(u32x4_t*)(sb_ + 64 * G_ROWB) = rb2; *(u32x4_t*)(sb_ + 96 * G_ROWB) = rb3;         \
  }
#define GM_COMPUTE()                                                                    \
  {                                                                                     \
    const char* sa_ = smem + (wm * 128 + r) * G_ROWB + h * 16;                          \
    const char* sb_ = smem + G_ATILE + (wn * 64 + r) * G_ROWB + h * 16;                 \
    _Pragma("unroll") for (int ks = 0; ks < 4; ++ks) {                                  \
      bf16x8 b0 = *(const bf16x8*)(sb_ + ks * 32);                                      \
      bf16x8 b1 = *(const bf16x8*)(sb_ + 32 * G_ROWB + ks * 32);                        \
      _Pragma("unroll") for (int i = 0; i < 4; ++i) {                                   \
        bf16x8 a = *(const bf16x8*)(sa_ + i * 32 * G_ROWB + ks * 32);                   \
        acc[i][0] = MFMA(a, b0, acc[i][0]);                                             \
        acc[i][1] = MFMA(a, b1, acc[i][1]);                                             \
      }                                                                                 \
    }                                                                                   \
  }

  GM_LOADG(0);
  GM_WAIT0();
  GM_STOREL();
  __syncthreads();
  if (nIter > 1) GM_LOADG(1);
#pragma unroll 1
  for (int it = 0; it < nIter; ++it) {
    if (EPI == EPI_OUT) {
      if (it == segIters || it == 2 * segIters) {
        const float* fac = (it == segIters) ? rs : f3;
#pragma unroll
        for (int i = 0; i < 4; ++i)
#pragma unroll
          for (int q = 0; q < 16; ++q) {
            float f = fac[wm * 128 + i * 32 + crow(q, h)];
            acc[i][0][q] *= f; acc[i][1][q] *= f;
          }
      }
    }
    __builtin_amdgcn_s_setprio(1);
    GM_COMPUTE();
    __builtin_amdgcn_s_setprio(0);
    __syncthreads();
    if (it + 1 < nIter) {
      GM_WAIT0();
      GM_STOREL();
    }
    __syncthreads();
    if (it + 2 < nIter) GM_LOADG(it + 2);
  }

  float* Cw = (float*)(smem + wave * CW_BYTES);
  const int ncol0 = n0 + wn * 64;
#pragma unroll
  for (int i = 0; i < 4; ++i) {
    const int mrow0 = wm * 128 + i * 32;
#pragma unroll
    for (int j = 0; j < 2; ++j)
#pragma unroll
      for (int q = 0; q < 16; ++q) Cw[crow(q, h) * CW_LD + j * 32 + r] = acc[i][j][q];
    __builtin_amdgcn_fence(__ATOMIC_RELEASE, "wavefront");
    if (EPI == EPI_KV && ((ncol0 >> 7) & 1)) {
      const int hh = ncol0 >> 8, c = (ncol0 & 127) + lane;
      const int b = m0 >> 13, s0 = (m0 & (SEQ - 1)) + mrow0;
      bf16_t* vt = (bf16_t*)(ws + OFF_VT) + (((size_t)((b * 4 + hh) * 128 + (s0 >> 6))) * 128 + c) * 64 + (s0 & 63);
#pragma unroll
      for (int g8 = 0; g8 < 4; ++g8) {
        float v[8];
#pragma unroll
        for (int k = 0; k < 8; ++k) v[k] = Cw[(g8 * 8 + k) * CW_LD + lane] * rs[mrow0 + g8 * 8 + k];
        uint4 o; o.x = pack2(v[0], v[1]); o.y = pack2(v[2], v[3]); o.z = pack2(v[4], v[5]); o.w = pack2(v[6], v[7]);
        *(uint4*)(vt + g8 * 8) = o;
      }
    } else if (EPI == EPI_GU) {
      const int L8 = lane & 7, rs8 = lane >> 3;
#pragma unroll 2
      for (int p = 0; p < 4; ++p) {
        const int row = p * 8 + rs8, m = m0 + mrow0 + row;
        float4 v0 = *(const float4*)(Cw + row * CW_LD + 4 * L8);
        float4 v1 = *(const float4*)(Cw + row * CW_LD + 32 + 4 * L8);
        float s = rs[mrow0 + row];
        float gx[4] = {v0.x * s, v0.y * s, v0.z * s, v0.w * s};
        float ux[4] = {v1.x * s, v1.y * s, v1.z * s, v1.w * s};
        float a[4];
#pragma unroll
        for (int q = 0; q < 4; ++q) a[q] = gx[q] * sigmoidf_(gx[q]) * ux[q];
        uint2 u; u.x = pack2(a[0], a[1]); u.y = pack2(a[2], a[3]);
        *(uint2*)((bf16_t*)(ws + OFF_ACT) + (size_t)m * LD_ACT + (ncol0 >> 1) + 4 * L8) = u;
      }
    } else {
      const int L = lane & 15, rsub = lane >> 4;
      constexpr int UNR_ = (EPI == EPI_OUT || EPI == EPI_DOWN) ? 4 : 2;
#pragma clang loop unroll_count(UNR_)
      for (int p = 0; p < 8; ++p) {
        const int row = p * 4 + rsub, trow = mrow0 + row, m = m0 + trow;
        const int n = ncol0 + 4 * L;
        float4 v = *(const float4*)(Cw + row * CW_LD + 4 * L);
        if (EPI == EPI_PROJ) {
          float s = rs[trow];
          uint2 o; o.x = pack2(v.x * s, v.y * s); o.y = pack2(v.z * s, v.w * s);
          if (n < 704) *(uint2*)((bf16_t*)(ws + OFF_PROJA) + (size_t)m * 704 + n) = o;
          else if (n < 2752) *(uint2*)((bf16_t*)(ws + OFF_PROJH) + (size_t)m * LD_PH + (n - 704)) = o;
          else if (n < 3264) *(uint2*)((bf16_t*)(ws + OFF_PROJM) + (size_t)m * LD_PM + (n - 2752)) = o;
          if (ncol0 < 640) {
            float q0_ = lo2f(o.x), q1_ = hi2f(o.x), q2_ = lo2f(o.y), q3_ = hi2f(o.y);
            float ssq = q0_ * q0_ + q1_ * q1_ + q2_ * q2_ + q3_ * q3_;
            ssq += __shfl_xor(ssq, 1, 64); ssq += __shfl_xor(ssq, 2, 64); ssq += __shfl_xor(ssq, 4, 64); ssq += __shfl_xor(ssq, 8, 64);
            if (L == 0) atomicAdd((float*)(ws + OFF_SSL) + (ncol0 < 384 ? 0 : T_TOK) + m, ssq);
          }
        } else if (EPI == EPI_MEMKV) {
          float s = rs[trow];
          *(float4*)((float*)(ws + OFF_MEMKV) + (size_t)m * 1024 + n) = make_float4(v.x * s, v.y * s, v.z * s, v.w * s);
        } else if (EPI == EPI_Q) {
          float s = rs[trow];
          uint2 u; u.x = pack2(v.x * s, v.y * s); u.y = pack2(v.z * s, v.w * s);
          *(uint2*)((bf16_t*)(ws + OFF_Q) + (size_t)m * 768 + n) = u;
        } else if (EPI == EPI_KV) {
          float s = rs[trow];
          uint2 u; u.x = pack2(v.x * s, v.y * s); u.y = pack2(v.z * s, v.w * s);
          *(uint2*)((bf16_t*)(ws + OFF_K) + ((size_t)((m >> 13) * 4 + (n >> 8)) * SEQ + (m & (SEQ - 1))) * 192 + (n & 127)) = u;
        } else if (EPI == EPI_OUT) {
          float4 xin = *(const float4*)(P.x + (size_t)m * 1024 + n);
          float4 o = make_float4(xin.x + v.x, xin.y + v.y, xin.z + v.z, xin.w + v.w);
          *(float4*)(P.out + (size_t)m * 1024 + n) = o;
          uint2 u; u.x = pack2(o.x, o.y); u.y = pack2(o.z, o.w);
          *(uint2*)((bf16_t*)(ws + OFF_X1B) + (size_t)m * LD_XB + n) = u;
          float ssq = o.x * o.x + o.y * o.y + o.z * o.z + o.w * o.w;
          ssq += __shfl_xor(ssq, 1, 64); ssq += __shfl_xor(ssq, 2, 64); ssq += __shfl_xor(ssq, 4, 64); ssq += __shfl_xor(ssq, 8, 64);
          if (L == 0) atomicAdd((float*)(ws + OFF_SS) + 2 * T_TOK + m, ssq);
        } else if (EPI == EPI_DOWN) {
          float4 xin = *(const float4*)(P.out + (size_t)m * 1024 + n);
          *(float4*)(P.out + (size_t)m * 1024 + n) = make_float4(xin.x + v.x, xin.y + v.y, xin.z + v.z, xin.w + v.w);
        }
      }
    }
    __builtin_amdgcn_fence(__ATOMIC_ACQUIRE, "wavefront");
  }
  __syncthreads();
}

DI GArgs garg1(const bf16_t* A, int lda, int K, const bf16_t* Bt, int ldb) {
  GArgs g;
  g.A0 = g.A1 = g.A2 = A; g.lda0 = g.lda1 = g.lda2 = lda; g.kb0 = g.kb1 = g.kb2 = 0;
  g.segIters = K / 64; g.nIter = K / 64; g.Ktot = K; g.Bt = Bt; g.ldb = ldb;
  return g;
}

DI void tile_mn(int t, int NT, int& mt, int& nt) {
  int grp = t / (32 * NT), rem = t - grp * 32 * NT;
  nt = rem >> 5; mt = grp * 32 + (rem & 31);
}

__device__ void phase1(const Params& P, int bid, int nb, char* smem) {
  char* ws = P.ws;
  GArgs g1 = garg1((const bf16_t*)(ws + OFF_XB), LD_XB, 1024, (const bf16_t*)(ws + OFF_WT_IN), LD_WIN);
  GArgs g2 = garg1((const bf16_t*)(ws + OFF_MEMB), 1024, 1024, (const bf16_t*)(ws + OFF_WT_MKV), LD_WMKV);
  constexpr int NT1 = 64 * 26;
  for (int t = bid; t < NT1 + 16; t += nb) {
    if (t < NT1) { int mt, nt; tile_mn(t, 26, mt, nt); gemm_tile<EPI_PROJ>(P, g1, mt * 256, nt * 128, smem); }
    else { int u = t - NT1; gemm_tile<EPI_MEMKV>(P, g2, (u & 1) * 256, (u >> 1) * 128, smem); }
  }
  {
    const int rem = (NT1 + 16) % nb;
    const int first = rem == 0 ? 0 : rem, stride = nb - first;
    if (bid >= first)
      for (int u = bid - first; u < 2496; u += stride) prep_transpose_job(P, 1224 + u, smem);
  }
}

constexpr int VT_ROWB = 144;
constexpr int QK_ROWB = 272;
DI void hg_tile_to_lds(const bf16_t* src, char* dst) {
  const int tid = threadIdx.x;
  uint4 v0, v1, v2, v3;
  {
    const int t = tid >> 4, dc = tid & 15;
    const bf16_t* p = src + (size_t)t * LD_PH + dc * 8;
    v0 = *(const uint4*)(p); v1 = *(const uint4*)(p + (size_t)16 * LD_PH);
    v2 = *(const uint4*)(p + (size_t)32 * LD_PH); v3 = *(const uint4*)(p + (size_t)48 * LD_PH);
    char* d = dst + t * QK_ROWB + dc * 16;
    *(uint4*)(d) = v0; *(uint4*)(d + 16 * QK_ROWB) = v1; *(uint4*)(d + 32 * QK_ROWB) = v2; *(uint4*)(d + 48 * QK_ROWB) = v3;
  }
}
DI void hg_build_vT(const bf16_t* src, char* svT) {
  const int tid = threadIdx.x;
  const int t = tid & 63, dc0 = tid >> 6;
  uint4 v0, v1, v2, v3;
  const bf16_t* p = src + (size_t)t * LD_PH + dc0 * 8;
  v0 = *(const uint4*)(p); v1 = *(const uint4*)(p + 32); v2 = *(const uint4*)(p + 64); v3 = *(const uint4*)(p + 96);
#define HG_SCATTER(v, i)                                                        \
  {                                                                             \
    char* d = svT + ((dc0 + 4 * (i)) * 8) * VT_ROWB + t * 2;                    \
    *(bf16_t*)(d) = (bf16_t)(v.x & 0xffff); *(bf16_t*)(d + VT_ROWB) = (bf16_t)(v.x >> 16);             \
    *(bf16_t*)(d + 2 * VT_ROWB) = (bf16_t)(v.y & 0xffff); *(bf16_t*)(d + 3 * VT_ROWB) = (bf16_t)(v.y >> 16); \
    *(bf16_t*)(d + 4 * VT_ROWB) = (bf16_t)(v.z & 0xffff); *(bf16_t*)(d + 5 * VT_ROWB) = (bf16_t)(v.z >> 16); \
    *(bf16_t*)(d + 6 * VT_ROWB) = (bf16_t)(v.w & 0xffff); *(bf16_t*)(d + 7 * VT_ROWB) = (bf16_t)(v.w >> 16); \
  }
  HG_SCATTER(v0, 0) HG_SCATTER(v1, 1) HG_SCATTER(v2, 2) HG_SCATTER(v3, 3)
}

__device__ void hg_local_state(const Params& P, int item, char* smem) {
  char* ws = P.ws;
  const int tid = threadIdx.x, lane = tid & 63, wave = tid >> 6, r = lane & 31, h = lane >> 5;
  const int bh = item >> 7, c = item & 127, b = bh >> 2, hh = bh & 3;
  const int t0 = b * SEQ + c * 64;
  char* svT = smem;
  char* skT = smem + 128 * VT_ROWB;
  char* sraw = smem + 256 * VT_ROWB;
  const bf16_t* src = (const bf16_t*)(ws + OFF_PROJH) + (size_t)t0 * LD_PH + hh * 128;
  hg_tile_to_lds(src + 512, sraw);
  hg_build_vT(src + 1024, svT);
  __syncthreads();
  if (tid < 128) {
    const int d = tid;
    const float lb = ((const float*)(ws + OFF_LB))[hh * 128 + d];
    float run = 0.f;
    for (int j = 7; j >= 0; --j) {
      float v[8];
#pragma unroll
      for (int i = 7; i >= 0; --i) {
        float f = lb + (1.f - lb) * sigmoidf_(bf2f(*(const bf16_t*)(sraw + (8 * j + i) * QK_ROWB + d * 2)));
        v[i] = (1.f - f) * __builtin_amdgcn_exp2f(run);
        run += __builtin_amdgcn_logf(f);
      }
      uint4 o; o.x = pack2(v[0], v[1]); o.y = pack2(v[2], v[3]); o.z = pack2(v[4], v[5]); o.w = pack2(v[6], v[7]);
      *(uint4*)(skT + d * VT_ROWB + j * 16) = o;
    }
    ((float*)(ws + OFF_DEC))[(size_t)(bh * 128 + c) * 128 + d] = __builtin_amdgcn_exp2f(run);
  }
  __syncthreads();
  f32x16 acc[4];
  for (int i = 0; i < 4; ++i) acc[i] = zero16();
#pragma unroll
  for (int ks = 0; ks < 4; ++ks) {
    bf16x8 a = *(const bf16x8*)(svT + (wave * 32 + r) * VT_ROWB + ks * 32 + h * 16);
#pragma unroll
    for (int dt = 0; dt < 4; ++dt) {
      bf16x8 bb = *(const bf16x8*)(skT + (dt * 32 + r) * VT_ROWB + ks * 32 + h * 16);
      acc[dt] = MFMA(a, bb, acc[dt]);
    }
  }
  bf16_t* L = (bf16_t*)(ws + OFF_L) + (size_t)(bh * 128 + c) * 16384;
#pragma unroll
  for (int dt = 0; dt < 4; ++dt)
#pragma unroll
    for (int q = 0; q < 16; ++q) L[(wave * 32 + crow(q, h)) * 128 + dt * 32 + r] = f2bf(acc[dt][q]);
  __syncthreads();
}

__device__ void phase2(const Params& P, int bid, int nb, char* smem) {
  char* ws = P.ws;
  GArgs gq = garg1((const bf16_t*)(ws + OFF_PROJA), 704, 384, (const bf16_t*)(ws + OFF_WT_UQ), LD_WUQ);
  GArgs gkv = garg1((const bf16_t*)(ws + OFF_PROJA) + 384, 704, 256, (const bf16_t*)(ws + OFF_WT_UKV), LD_WUKV);
  constexpr int NQ = 64 * 6, NKV = 64 * 8, NH = 1024;
  for (int t = bid; t < NQ + NKV + NH; t += nb) {
    if (t < NQ) { int mt, nt; tile_mn(t, 6, mt, nt); gemm_tile<EPI_Q>(P, gq, mt * 256, nt * 128, smem); }
    else if (t < NQ + NKV) { int mt, nt; tile_mn(t - NQ, 8, mt, nt); gemm_tile<EPI_KV>(P, gkv, mt * 256, nt * 128, smem); }
    else hg_local_state(P, t - NQ - NKV, smem);
  }
}

__device__ void phase3(const Params& P, int bid, int nb, char* smem) {
  char* ws = P.ws;
  const int tid = threadIdx.x, lane = tid & 63, wave = tid >> 6;
  constexpr int J_SCAN = 512, J_NORM = 4096, J_MEMK = 128;
  for (int job = bid; job < J_SCAN + J_NORM + J_MEMK; job += nb) {
    if (job < J_SCAN) {
      int idx = job * 256 + tid;
      int d = idx & 127, e = (idx >> 7) & 127, bh = idx >> 14;
      bf16_t* L = (bf16_t*)(ws + OFF_L) + (size_t)bh * 128 * 16384 + e * 128 + d;
      const float* dec = (const float*)(ws + OFF_DEC) + (size_t)bh * 128 * 128 + d;
      float S = 0.f;
      float tA[16], dA[16], tB[16], dB[16];
#pragma unroll
      for (int i = 0; i < 16; ++i) { tA[i] = bf2f(L[(size_t)i * 16384]); dA[i] = dec[i * 128]; }
#pragma unroll 1
      for (int c0 = 0; c0 < 128; c0 += 32) {
#pragma unroll
        for (int i = 0; i < 16; ++i) { tB[i] = bf2f(L[(size_t)(c0 + 16 + i) * 16384]); dB[i] = dec[(c0 + 16 + i) * 128]; }
#pragma unroll
        for (int i = 0; i < 16; ++i) { L[(size_t)(c0 + i) * 16384] = f2bf(S); S = dA[i] * S + tA[i]; }
        if (c0 + 32 < 128) {
#pragma unroll
          for (int i = 0; i < 16; ++i) { tA[i] = bf2f(L[(size_t)(c0 + 32 + i) * 16384]); dA[i] = dec[(c0 + 32 + i) * 128]; }
        }
#pragma unroll
        for (int i = 0; i < 16; ++i) { L[(size_t)(c0 + 16 + i) * 16384] = f2bf(S); S = dB[i] * S + tB[i]; }
      }
      continue;
    }
    int j = job - J_SCAN;
    if (j < J_NORM) {
      const int t = j * 4 + wave;
      const float cs = ((const float*)(ws + OFF_COS))[t * 32 + (lane & 31)];
      const float sn = ((const float*)(ws + OFF_SIN))[t * 32 + (lane & 31)];
      const float sgn = lane < 32 ? -1.f : 1.f;
      const float qscale = 0.07216878364870322f * LOG2E;
      bf16_t* Q = (bf16_t*)(ws + OFF_Q) + (size_t)t * 768;
      bf16_t* K = (bf16_t*)(ws + OFF_K) + ((size_t)((t >> 13) * 4) * SEQ + (t & (SEQ - 1))) * 192;
      const float kr = bf2f(((const bf16_t*)(ws + OFF_PROJA))[(size_t)t * 704 + 640 + lane]);
      const float gq0 = P.mla_q_norm[lane], gq1 = P.mla_q_norm[64 + lane], gq2 = P.mla_q_norm[128 + lane];
      const float gk0 = P.mla_k_norm[lane], gk1 = P.mla_k_norm[64 + lane], gk2 = P.mla_k_norm[128 + lane];
      bf16_t* M = (bf16_t*)(ws + OFF_PROJM) + (size_t)t * LD_PM;
      const float gm0 = P.mem_q_norm[lane], gm1 = P.mem_q_norm[64 + lane];
      float qv[4][3], kv[4][2], mv[4][2];
#pragma unroll
      for (int hh = 0; hh < 4; ++hh) {
        qv[hh][0] = bf2f(Q[hh * 192 + lane]); qv[hh][1] = bf2f(Q[hh * 192 + 64 + lane]); qv[hh][2] = bf2f(Q[hh * 192 + 128 + lane]);
        kv[hh][0] = bf2f(K[(size_t)hh * SEQ * 192 + lane]); kv[hh][1] = bf2f(K[(size_t)hh * SEQ * 192 + 64 + lane]);
        mv[hh][0] = bf2f(M[hh * 128 + lane]); mv[hh][1] = bf2f(M[hh * 128 + 64 + lane]);
      }
      float sq[4], sk[4], sm[4];
#pragma unroll
      for (int hh = 0; hh < 4; ++hh) {
        sq[hh] = qv[hh][0] * qv[hh][0] + qv[hh][1] * qv[hh][1] + qv[hh][2] * qv[hh][2];
        sk[hh] = kv[hh][0] * kv[hh][0] + kv[hh][1] * kv[hh][1] + kr * kr;
        sm[hh] = mv[hh][0] * mv[hh][0] + mv[hh][1] * mv[hh][1];
      }
#pragma unroll
      for (int o = 32; o >= 1; o >>= 1) {
#pragma unroll
        for (int hh = 0; hh < 4; ++hh) {
          sq[hh] += __shfl_xor(sq[hh], o, 64); sk[hh] += __shfl_xor(sk[hh], o, 64); sm[hh] += __shfl_xor(sm[hh], o, 64);
        }
      }
#pragma unroll
      for (int hh = 0; hh < 4; ++hh) {
        {
          float rstd = rsqrtf(sq[hh] * (1.f / 192.f) + EPS);
          float n0 = qv[hh][0] * rstd * gq0, n1 = qv[hh][1] * rstd * gq1, n2 = qv[hh][2] * rstd * gq2;
          float pr = __shfl_xor(n2, 32, 64);
          float ro = n2 * cs + sgn * pr * sn;
          Q[hh * 192 + lane] = f2bf(n0 * qscale); Q[hh * 192 + 64 + lane] = f2bf(n1 * qscale); Q[hh * 192 + 128 + lane] = f2bf(ro * qscale);
        }
        {
          float rstd = rsqrtf(sk[hh] * (1.f / 192.f) + EPS);
          float n0 = kv[hh][0] * rstd * gk0, n1 = kv[hh][1] * rstd * gk1, n2 = kr * rstd * gk2;
          float pr = __shfl_xor(n2, 32, 64);
          float ro = n2 * cs + sgn * pr * sn;
          K[(size_t)hh * SEQ * 192 + lane] = f2bf(n0); K[(size_t)hh * SEQ * 192 + 64 + lane] = f2bf(n1); K[(size_t)hh * SEQ * 192 + 128 + lane] = f2bf(ro);
        }
        {
          float rstd = rsqrtf(sm[hh] * (1.f / 128.f) + EPS) * (0.08838834764831845f * LOG2E);
          M[hh * 128 + lane] = f2bf(mv[hh][0] * rstd * gm0); M[hh * 128 + 64 + lane] = f2bf(mv[hh][1] * rstd * gm1);
        }
      }
      continue;
    }
    j -= J_NORM;
    {
      const int m = j * 4 + wave;
      const int b = m >> 8, key = m & 255;
      const float* src = (const float*)(ws + OFF_MEMKV) + (size_t)m * 1024;
      for (int hh = 0; hh < 4; ++hh) {
        float v0 = src[hh * 128 + lane], v1 = src[hh * 128 + 64 + lane];
        float ss = wave_sum(v0 * v0 + v1 * v1);
        float rstd = rsqrtf(ss * (1.f / 128.f) + EPS);
        bf16_t* km = (bf16_t*)(ws + OFF_KMEM) + ((size_t)((b * 4 + hh) * 256 + key)) * 128;
        km[lane] = f2bf(v0 * rstd * P.mem_k_norm[lane]); km[64 + lane] = f2bf(v1 * rstd * P.mem_k_norm[64 + lane]);
        bf16_t* vm = (bf16_t*)(ws + OFF_VMEMT) + ((size_t)(b * 4 + hh) * 128) * 256 + key;
        vm[(size_t)lane * 256] = f2bf(src[512 + hh * 128 + lane]);
        vm[(size_t)(64 + lane) * 256] = f2bf(src[512 + hh * 128 + 64 + lane]);
      }
    }
  }
}

constexpr int AV_ROWB = 136;
template <int DQK, bool CAUSAL>
__device__ __forceinline__ void attn_item(const bf16_t* Q, int ldq, const bf16_t* K, int ldk, const bf16_t* Vt, int ldv, int vts, int q0, int nkeys,
                          bf16_t* Y, int ldy, float* ssout, char* smem) {
  constexpr int KROWB = (DQK + 8) * 2;
  constexpr int KCH = DQK / 8;
  constexpr int NKL = (64 * KCH) / 256;
  constexpr int NKS = DQK / 16;
  int tid = threadIdx.x;
  asm volatile("" : "+v"(tid));
  const int lane = tid & 63, wave = tid >> 6, r = lane & 31, h = lane >> 5;
  const int rg = wave & 1, kh = wave >> 1;
  char* sK = smem;
  char* sV = smem + 64 * KROWB;
  const int qrow = q0 + rg * 32 + r;

  char* sQ = smem + 64 * KROWB + 128 * AV_ROWB;
  f32x16 oacc[4];
  for (int i = 0; i < 4; ++i) oacc[i] = zero16();
  float m_run = -INFINITY, l_run = 0.f;
  const int ntiles = CAUSAL ? (q0 + 64) / 64 : nkeys / 64;

  uint4 rk0, rk1, rk2, rk3, rk4, rk5, rv0, rv1, rv2, rv3;
  rk4 = make_uint4(0, 0, 0, 0); rk5 = rk4;
#define AT_KOFF(i) ((unsigned)(((tid + 256 * (i)) / KCH) * ldk + ((tid + 256 * (i)) % KCH) * 8) * 2u)
#define AT_VOFF(i) ((unsigned)(((tid + 256 * (i)) >> 3) * ldv + ((tid + 256 * (i)) & 7) * 8) * 2u)
#define AT_KLDS(i) (sK + ((tid + 256 * (i)) / KCH) * KROWB + ((tid + 256 * (i)) % KCH) * 16)
#define AT_VLDS(i) (sV + ((tid + 256 * (i)) >> 3) * AV_ROWB + ((tid + 256 * (i)) & 7) * 16)
#define AT_LOADG(kt_)                                                                   \
  {                                                                                     \
    const char* kb_ = (const char*)(K + (size_t)(kt_) * 64 * ldk);                      \
    const char* vb_ = (const char*)(Vt + (size_t)(kt_) * vts);                          \
    rk0 = *(const uint4*)(kb_ + AT_KOFF(0)); rk1 = *(const uint4*)(kb_ + AT_KOFF(1));   \
    rk2 = *(const uint4*)(kb_ + AT_KOFF(2)); rk3 = *(const uint4*)(kb_ + AT_KOFF(3));   \
    if (NKL > 4) { rk4 = *(const uint4*)(kb_ + AT_KOFF(4)); rk5 = *(const uint4*)(kb_ + AT_KOFF(5)); } \
    rv0 = *(const uint4*)(vb_ + AT_VOFF(0)); rv1 = *(const uint4*)(vb_ + AT_VOFF(1));   \
    rv2 = *(const uint4*)(vb_ + AT_VOFF(2)); rv3 = *(const uint4*)(vb_ + AT_VOFF(3));   \
  }
#define AT_VST(i, v)                                                    \
  {                                                                     \
    *(uint2*)(AT_VLDS(i)) = make_uint2(v.x, v.y);                       \
    *(uint2*)(AT_VLDS(i) + 8) = make_uint2(v.z, v.w);                   \
  }
#define AT_STOREL()                                                                     \
  {                                                                                     \
    *(uint4*)(AT_KLDS(0)) = rk0; *(uint4*)(AT_KLDS(1)) = rk1;                           \
    *(uint4*)(AT_KLDS(2)) = rk2; *(uint4*)(AT_KLDS(3)) = rk3;                           \
    if (NKL > 4) { *(uint4*)(AT_KLDS(4)) = rk4; *(uint4*)(AT_KLDS(5)) = rk5; }          \
    AT_VST(0, rv0) AT_VST(1, rv1) AT_VST(2, rv2) AT_VST(3, rv3)                         \
  }

  AT_LOADG(0);
  for (int c = tid; c < 64 * KCH; c += 256) {
    const int row = c / KCH, kc = c - row * KCH;
    *(uint4*)(sQ + row * KROWB + kc * 16) = *(const uint4*)(Q + (size_t)(q0 + row) * ldq + kc * 8);
  }

  AT_STOREL();
  __syncthreads();
  for (int kt = 0; kt < ntiles; ++kt) {
    if (kt + 1 < ntiles) AT_LOADG(kt + 1);
    __builtin_amdgcn_sched_barrier(0);
    const int k0 = kt * 64 + kh * 32;
    f32x16 sc = zero16();
    __builtin_amdgcn_s_setprio(1);
#pragma unroll
    for (int ks = 0; ks < NKS; ++ks) {
      bf16x8 a0 = *(const bf16x8*)(sK + (kh * 32 + r) * KROWB + ks * 32 + h * 16);
      bf16x8 bq = *(const bf16x8*)(sQ + (rg * 32 + r) * KROWB + ks * 32 + h * 16);
      sc = MFMA(a0, bq, sc);

    }
    if (CAUSAL) {
      if (k0 + 31 > q0 + rg * 32) {
#pragma unroll
        for (int q = 0; q < 16; ++q) {
          int key = k0 + crow(q, h);
          if (key > qrow) sc[q] = -INFINITY;
        }
      }
    }
    float mx = sc[0];
#pragma unroll
    for (int q = 1; q < 16; ++q) mx = fmaxf(mx, sc[q]);
    {
      auto sw = __builtin_amdgcn_permlane32_swap(__float_as_uint(mx), __float_as_uint(mx), false, false);
      mx = fmaxf(__uint_as_float(sw[0]), __uint_as_float(sw[1]));
    }
    if (__builtin_amdgcn_ballot_w64(mx > m_run + 8.f) != 0ull) {
      const float m_new = fmaxf(m_run, mx);
      const float m_safe = (m_new == -INFINITY) ? 0.f : m_new;
      const float alpha = __builtin_amdgcn_exp2f(m_run - m_safe);
      m_run = m_new;
      l_run *= alpha;
#pragma unroll
      for (int dt = 0; dt < 4; ++dt)
#pragma unroll
        for (int q = 0; q < 16; ++q) oacc[dt][q] *= alpha;
    }
    const float m_ref = (m_run == -INFINITY) ? 0.f : m_run;
    float ls = 0.f;
#pragma unroll
    for (int q = 0; q < 16; ++q) { sc[q] = __builtin_amdgcn_exp2f(sc[q] - m_ref); ls += sc[q]; }
    l_run += ls;
#pragma unroll
    for (int s2 = 0; s2 < 2; ++s2) {
      bf16x8 pb = pack8(sc, s2);
#pragma unroll
      for (int dt = 0; dt < 4; ++dt) {
        const char* vp = sV + (dt * 32 + r) * AV_ROWB + (32 * kh + 16 * s2 + 4 * h) * 2;
        uint2 lo = *(const uint2*)vp;
        uint2 hi = *(const uint2*)(vp + 16);
        uint4 av = make_uint4(lo.x, lo.y, hi.x, hi.y);
        oacc[dt] = MFMA(__builtin_bit_cast(bf16x8, av), pb, oacc[dt]);
      }
      __builtin_amdgcn_sched_barrier(0);
    }
    __builtin_amdgcn_s_setprio(0);
    __syncthreads();
    if (kt + 1 < ntiles) { AT_STOREL(); }
    __syncthreads();
  }
  float* mO = (float*)smem + rg * (66 * 64);
  if (kh == 1) {
#pragma unroll
    for (int dt = 0; dt < 4; ++dt)
#pragma unroll
      for (int q = 0; q < 16; ++q) mO[(dt * 16 + q) * 64 + lane] = oacc[dt][q];
    mO[64 * 64 + lane] = m_run;
    mO[65 * 64 + lane] = l_run;
  }
  __syncthreads();
  if (kh == 0) {
    const float m_b = mO[64 * 64 + lane], l_b = mO[65 * 64 + lane];
    const float m = fmaxf(m_run, m_b);
    const float fa = __builtin_amdgcn_exp2f(m_run - m), fb = __builtin_amdgcn_exp2f(m_b - m);
    float lsum = l_run * fa + l_b * fb;
    lsum += __shfl_xor(lsum, 32, 64);
    const float inv = 1.f / lsum;
    const float ca = fa * inv, cb = fb * inv;
    float ssq = 0.f;
#pragma unroll
    for (int dt = 0; dt < 4; ++dt)
#pragma unroll
      for (int g4 = 0; g4 < 4; ++g4) {
        float o0 = oacc[dt][4 * g4] * ca + mO[(dt * 16 + 4 * g4) * 64 + lane] * cb;
        float o1 = oacc[dt][4 * g4 + 1] * ca + mO[(dt * 16 + 4 * g4 + 1) * 64 + lane] * cb;
        float o2 = oacc[dt][4 * g4 + 2] * ca + mO[(dt * 16 + 4 * g4 + 2) * 64 + lane] * cb;
        float o3 = oacc[dt][4 * g4 + 3] * ca + mO[(dt * 16 + 4 * g4 + 3) * 64 + lane] * cb;
        ssq += o0 * o0 + o1 * o1 + o2 * o2 + o3 * o3;
        uint2 u; u.x = pack2(o0, o1); u.y = pack2(o2, o3);
        *(uint2*)(Y + (size_t)qrow * ldy + dt * 32 + 8 * g4 + 4 * h) = u;
      }
    ssq += __shfl_xor(ssq, 32, 64);
    if (h == 0) atomicAdd(ssout + qrow, ssq);
  }
  __syncthreads();
}

template <int DQK, bool CAUSAL>
__device__ __forceinline__ void attn_item128(const bf16_t* Q, int ldq, const bf16_t* K, int ldk, const bf16_t* Vt, int ldv, int vts,
                                          int q0, int kt0, int kt1, bf16_t* Y, int ldy, float* ssout, char* smem) {
  constexpr int KROWB = (DQK + 8) * 2;
  constexpr int KCH = DQK / 8;
  constexpr int NKL = (64 * KCH) / 256;
  constexpr int NKS = DQK / 16;
  int tid = threadIdx.x;
  asm volatile("" : "+v"(tid));
  const int lane = tid & 63, wave = tid >> 6, r = lane & 31, h = lane >> 5;
  char* sK = smem;
  char* sV = smem + 64 * KROWB;
  const int qrow = q0 + wave * 32 + r;

  bf16x8 qf[NKS];
#pragma unroll
  for (int ks = 0; ks < NKS; ++ks) qf[ks] = *(const bf16x8*)(Q + (size_t)qrow * ldq + ks * 16 + h * 8);

  f32x16 oacc[4];
  for (int i = 0; i < 4; ++i) oacc[i] = zero16();
  float m_run = -INFINITY, l_run = 0.f;

  uint4 rk0, rk1, rk2, rk3, rk4, rk5, rv0, rv1, rv2, rv3;
  rk4 = make_uint4(0, 0, 0, 0); rk5 = rk4;
#define BAT_KOFF(i) ((unsigned)(((tid + 256 * (i)) / KCH) * ldk + ((tid + 256 * (i)) % KCH) * 8) * 2u)
#define BAT_VOFF(i) ((unsigned)(((tid + 256 * (i)) >> 3) * ldv + ((tid + 256 * (i)) & 7) * 8) * 2u)
#define BAT_KLDS(i) (sK + ((tid + 256 * (i)) / KCH) * KROWB + ((tid + 256 * (i)) % KCH) * 16)
#define BAT_VLDS(i) (sV + ((tid + 256 * (i)) >> 3) * AV_ROWB + ((tid + 256 * (i)) & 7) * 16)
#define BAT_LOADG(kt_)                                                                   \
  {                                                                                     \
    const char* kb_ = (const char*)(K + (size_t)(kt_) * 64 * ldk);                      \
    const char* vb_ = (const char*)(Vt + (size_t)(kt_) * vts);                          \
    rk0 = *(const uint4*)(kb_ + BAT_KOFF(0)); rk1 = *(const uint4*)(kb_ + BAT_KOFF(1));   \
    rk2 = *(const uint4*)(kb_ + BAT_KOFF(2)); rk3 = *(const uint4*)(kb_ + BAT_KOFF(3));   \
    if (NKL > 4) { rk4 = *(const uint4*)(kb_ + BAT_KOFF(4)); rk5 = *(const uint4*)(kb_ + BAT_KOFF(5)); } \
    rv0 = *(const uint4*)(vb_ + BAT_VOFF(0)); rv1 = *(const uint4*)(vb_ + BAT_VOFF(1));   \
    rv2 = *(const uint4*)(vb_ + BAT_VOFF(2)); rv3 = *(const uint4*)(vb_ + BAT_VOFF(3));   \
  }
#define BAT_VST(i, v)                                                    \
  {                                                                     \
    *(uint2*)(BAT_VLDS(i)) = make_uint2(v.x, v.y);                       \
    *(uint2*)(BAT_VLDS(i) + 8) = make_uint2(v.z, v.w);                   \
  }
#define BAT_STOREL()                                                                     \
  {                                                                                     \
    *(uint4*)(BAT_KLDS(0)) = rk0; *(uint4*)(BAT_KLDS(1)) = rk1;                           \
    *(uint4*)(BAT_KLDS(2)) = rk2; *(uint4*)(BAT_KLDS(3)) = rk3;                           \
    if (NKL > 4) { *(uint4*)(BAT_KLDS(4)) = rk4; *(uint4*)(BAT_KLDS(5)) = rk5; }          \
    BAT_VST(0, rv0) BAT_VST(1, rv1) BAT_VST(2, rv2) BAT_VST(3, rv3)                         \
  }

  BAT_LOADG(kt0);
  BAT_STOREL();
  __syncthreads();
  for (int kt = kt0; kt < kt1; ++kt) {
    if (kt + 1 < kt1) BAT_LOADG(kt + 1);
    __builtin_amdgcn_sched_barrier(0);
    __builtin_amdgcn_s_setprio(1);
#pragma unroll
    for (int kh = 0; kh < 2; ++kh) {
      const int k0 = kt * 64 + kh * 32;
      f32x16 sc = zero16();
#pragma unroll
      for (int ks = 0; ks < NKS; ++ks) {
        bf16x8 a0 = *(const bf16x8*)(sK + (kh * 32 + r) * KROWB + ks * 32 + h * 16);
        sc = MFMA(a0, qf[ks], sc);
      }
      if (CAUSAL) {
        if (k0 + 31 > q0 + wave * 32) {
#pragma unroll
          for (int q = 0; q < 16; ++q) {
            int key = k0 + crow(q, h);
            if (key > qrow) sc[q] = -INFINITY;
          }
        }
      }
      float mx = sc[0];
#pragma unroll
      for (int q = 1; q < 16; ++q) mx = fmaxf(mx, sc[q]);
      {
        auto sw = __builtin_amdgcn_permlane32_swap(__float_as_uint(mx), __float_as_uint(mx), false, false);
        mx = fmaxf(__uint_as_float(sw[0]), __uint_as_float(sw[1]));
      }
      if (__builtin_amdgcn_ballot_w64(mx > m_run + 8.f) != 0ull) {
        const float m_new = fmaxf(m_run, mx);
        const float m_safe = (m_new == -INFINITY) ? 0.f : m_new;
        const float alpha = __builtin_amdgcn_exp2f(m_run - m_safe);
        m_run = m_new;
        l_run *= alpha;
#pragma unroll
        for (int dt = 0; dt < 4; ++dt)
#pragma unroll
          for (int q = 0; q < 16; ++q) oacc[dt][q] *= alpha;
      }
      const float m_ref = (m_run == -INFINITY) ? 0.f : m_run;
      float ls = 0.f;
#pragma unroll
      for (int q = 0; q < 16; ++q) { sc[q] = __builtin_amdgcn_exp2f(sc[q] - m_ref); ls += sc[q]; }
      l_run += ls;
#pragma unroll
      for (int s2 = 0; s2 < 2; ++s2) {
        bf16x8 pb = pack8(sc, s2);
#pragma unroll
        for (int dt = 0; dt < 4; ++dt) {
          const char* vp = sV + (dt * 32 + r) * AV_ROWB + (32 * kh + 16 * s2 + 4 * h) * 2;
          uint2 lo = *(const uint2*)vp;
          uint2 hi = *(const uint2*)(vp + 16);
          uint4 av = make_uint4(lo.x, lo.y, hi.x, hi.y);
          oacc[dt] = MFMA(__builtin_bit_cast(bf16x8, av), pb, oacc[dt]);
        }
      }
      __builtin_amdgcn_sched_barrier(0);
    }
    __builtin_amdgcn_s_setprio(0);
    __syncthreads();
    if (kt + 1 < kt1) { BAT_STOREL(); }
    __syncthreads();
  }
  const float l = l_run + __shfl_xor(l_run, 32, 64);
  const float ca = 1.f / l;
  float ssq = 0.f;
#pragma unroll
  for (int dt = 0; dt < 4; ++dt)
#pragma unroll
    for (int g4 = 0; g4 < 4; ++g4) {
      float o0 = oacc[dt][4 * g4] * ca, o1 = oacc[dt][4 * g4 + 1] * ca, o2 = oacc[dt][4 * g4 + 2] * ca, o3 = oacc[dt][4 * g4 + 3] * ca;
      ssq += o0 * o0 + o1 * o1 + o2 * o2 + o3 * o3;
      uint2 u; u.x = pack2(o0, o1); u.y = pack2(o2, o3);
      *(uint2*)(Y + (size_t)qrow * ldy + dt * 32 + 8 * g4 + 4 * h) = u;
    }
  ssq += __shfl_xor(ssq, 32, 64);
  if (h == 0) atomicAdd(ssout + qrow, ssq);
}

__device__ void hg_output(const Params& P, int item, char* smem) {
  char* ws = P.ws;
  const int tid = threadIdx.x, lane = tid & 63, wave = tid >> 6, r = lane & 31, h = lane >> 5;
  const int bh = item >> 7, c = item & 127, b = bh >> 2, hh = bh & 3;
  const int t0 = b * SEQ + c * 64;
  char* sq = smem;
  char* sk = smem + 64 * QK_ROWB;
  char* svT = smem + 128 * QK_ROWB;
  float* ssum = (float*)(smem + 128 * QK_ROWB + 128 * VT_ROWB);
  {
    const bf16_t* src = (const bf16_t*)(ws + OFF_PROJH) + (size_t)t0 * LD_PH + hh * 128;
    hg_tile_to_lds(src, sq);
    hg_tile_to_lds(src + 512, sk);
    hg_build_vT(src + 1024, svT);
  }
  __syncthreads();
  if (tid < 128) {
    const int d = tid;
    const float lb = ((const float*)(ws + OFF_LB))[hh * 128 + d];
    float bc = 0.f;
    for (int t8 = 0; t8 < 64; t8 += 8) {
      float qv[8], fv[8];
#pragma unroll
      for (int i = 0; i < 8; ++i) {
        qv[i] = bf2f(*(const bf16_t*)(sq + (t8 + i) * QK_ROWB + d * 2));
        fv[i] = bf2f(*(const bf16_t*)(sk + (t8 + i) * QK_ROWB + d * 2));
      }
#pragma unroll
      for (int i = 0; i < 8; ++i) {
        float f = lb + (1.f - lb) * sigmoidf_(fv[i]);
        bc += __builtin_amdgcn_logf(f);
        float qs = qv[i] * sigmoidf_(qv[i]) * 0.08838834764831845f * __builtin_amdgcn_exp2f(bc);
        float kx = (1.f - f) * __builtin_amdgcn_exp2f(-bc);
        *(bf16_t*)(sq + (t8 + i) * QK_ROWB + d * 2) = f2bf(qs);
        *(bf16_t*)(sk + (t8 + i) * QK_ROWB + d * 2) = f2bf(kx);
      }
    }
  }
  __syncthreads();
  const int tt = wave & 1, eh = wave >> 1;
  f32x16 x0 = zero16(), x1 = zero16();
#pragma unroll
  for (int ks = 0; ks < 8; ++ks) {
    bf16x8 bq = *(const bf16x8*)(sq + (tt * 32 + r) * QK_ROWB + ks * 32 + h * 16);
    bf16x8 a0 = *(const bf16x8*)(sk + r * QK_ROWB + ks * 32 + h * 16);
    x0 = MFMA(a0, bq, x0);
    if (tt == 1) {
      bf16x8 a1 = *(const bf16x8*)(sk + (32 + r) * QK_ROWB + ks * 32 + h * 16);
      x1 = MFMA(a1, bq, x1);
    }
  }
  if (tt == 0) {
#pragma unroll
    for (int q = 0; q < 16; ++q) if (crow(q, h) > r) x0[q] = 0.f;
  } else {
#pragma unroll
    for (int q = 0; q < 16; ++q) if (crow(q, h) > r) x1[q] = 0.f;
  }
  f32x16 o[2];
  o[0] = zero16(); o[1] = zero16();
  const int nst = (tt == 0) ? 2 : 4;
#pragma unroll
  for (int s = 0; s < 4; ++s) {
    if (s < nst) {
      bf16x8 pb = (s < 2) ? pack8(x0, s & 1) : pack8(x1, s & 1);
#pragma unroll
      for (int et = 0; et < 2; ++et) {
        const char* vp = svT + ((eh * 2 + et) * 32 + r) * VT_ROWB + (16 * s + 4 * h) * 2;
        uint2 lo = *(const uint2*)vp;
        uint2 hi = *(const uint2*)(vp + 16);
        uint4 av = make_uint4(lo.x, lo.y, hi.x, hi.y);
        o[et] = MFMA(__builtin_bit_cast(bf16x8, av), pb, o[et]);
      }
    }
  }
  const bf16_t* St = (const bf16_t*)(ws + OFF_L) + (size_t)(bh * 128 + c) * 16384;
#pragma unroll
  for (int ks = 0; ks < 8; ++ks) {
    bf16x8 bq = *(const bf16x8*)(sq + (tt * 32 + r) * QK_ROWB + ks * 32 + h * 16);
#pragma unroll
    for (int et = 0; et < 2; ++et) {
      bf16x8 a = *(const bf16x8*)(St + ((eh * 2 + et) * 32 + r) * 128 + ks * 16 + h * 8);
      o[et] = MFMA(a, bq, o[et]);
    }
  }
  float ssq = 0.f;
#pragma unroll
  for (int et = 0; et < 2; ++et)
#pragma unroll
    for (int q = 0; q < 16; ++q) ssq += o[et][q] * o[et][q];
  ssq += __shfl_xor(ssq, 32, 64);
  if (h == 0) ssum[eh * 64 + tt * 32 + r] = ssq;
  __syncthreads();
  const float tot = ssum[tt * 32 + r] + ssum[64 + tt * 32 + r];
  const float rstd = rsqrtf(tot * (1.f / 128.f) + EPS);
  bf16_t* gp = (bf16_t*)(ws + OFF_PROJH) + (size_t)(t0 + tt * 32 + r) * LD_PH + 1536 + hh * 128;
#pragma unroll
  for (int et = 0; et < 2; ++et)
#pragma unroll
    for (int g4 = 0; g4 < 4; ++g4) {
      const int e = (eh * 2 + et) * 32 + 8 * g4 + 4 * h;
      uint2 gu = *(const uint2*)(gp + e);
      float4 gn = *(const float4*)(P.hg_out_norm + hh * 128 + e);
      float g0 = lo2f(gu.x), g1 = hi2f(gu.x), g2 = lo2f(gu.y), g3 = hi2f(gu.y);
      float y0 = o[et][4 * g4] * rstd * gn.x * g0 * sigmoidf_(g0);
      float y1 = o[et][4 * g4 + 1] * rstd * gn.y * g1 * sigmoidf_(g1);
      float y2 = o[et][4 * g4 + 2] * rstd * gn.z * g2 * sigmoidf_(g2);
      float y3 = o[et][4 * g4 + 3] * rstd * gn.w * g3 * sigmoidf_(g3);
      uint2 u; u.x = pack2(y0, y1); u.y = pack2(y2, y3);
      *(uint2*)(gp + e) = u;
    }
  __syncthreads();
}

DI int next_item(unsigned* cnt, int* s_item) {
  if (threadIdx.x == 0) *s_item = (int)atomicAdd(cnt, 1u);
  __syncthreads();
  const int item = *s_item;
  __syncthreads();
  return item;
}
__device__ void phase4(const Params& P, char* smem) {
  char* ws = P.ws;
  __shared__ int s_item;
  unsigned* cnt = (unsigned*)(ws + OFF_CNT);
  constexpr int N_MLA = 1024, N_MEM = 1024, N_H3 = 1024;
  while (true) {
    const int item = next_item(cnt, &s_item);
    if (item >= N_MLA) break;
    const int qt = 127 - (item >> 3), bh = item & 7, b = bh >> 2, hh = bh & 3;
    attn_item<192, true>((const bf16_t*)(ws + OFF_Q) + (size_t)b * SEQ * 768 + hh * 192, 768,
                         (const bf16_t*)(ws + OFF_K) + (size_t)bh * SEQ * 192, 192,
                         (const bf16_t*)(ws + OFF_VT) + (size_t)bh * 128 * 8192, 64, 8192, qt * 64, 0,
                         (bf16_t*)(ws + OFF_YMLA) + (size_t)b * SEQ * LD_YMLA + hh * 128, LD_YMLA,
                         (float*)(ws + OFF_SS) + b * SEQ, smem);
  }
  while (true) {
    const int u = next_item(cnt + 1, &s_item);
    if (u >= N_MEM / 2) break;
    const int bh = u & 7, qt = u >> 3, b = bh >> 2, hh = bh & 3;
    bf16_t* qp = (bf16_t*)(ws + OFF_PROJM) + (size_t)b * SEQ * LD_PM + hh * 128;
    attn_item128<128, false>(qp, LD_PM, (const bf16_t*)(ws + OFF_KMEM) + (size_t)bh * 256 * 128, 128,
                             (const bf16_t*)(ws + OFF_VMEMT) + (size_t)bh * 128 * 256, 256, 64, qt * 128, 0, 4, qp, LD_PM,
                             (float*)(ws + OFF_SS) + T_TOK + b * SEQ, smem);
  }
  while (true) {
    const int u = next_item(cnt + 2, &s_item);
    if (u >= N_H3) break;
    hg_output(P, u, smem);
  }
}

__device__ void phase5(const Params& P, int bid, int nb, char* smem) {
  char* ws = P.ws;
  GArgs g;
  g.A0 = (const bf16_t*)(ws + OFF_YMLA); g.lda0 = LD_YMLA; g.kb0 = 0;
  g.A1 = (const bf16_t*)(ws + OFF_PROJM); g.lda1 = LD_PM; g.kb1 = 1024;
  g.A2 = (const bf16_t*)(ws + OFF_PROJH) + 1536; g.lda2 = LD_PH; g.kb2 = 512;
  g.segIters = 8; g.nIter = 24; g.Ktot = 1536; g.Bt = (const bf16_t*)(ws + OFF_WT_OUT); g.ldb = LD_WOUT;
  for (int t = bid; t < 64 * 8; t += nb) { int mt, nt; tile_mn(t, 8, mt, nt); gemm_tile<EPI_OUT>(P, g, mt * 256, nt * 128, smem); }
}
__device__ void phase6(const Params& P, int bid, int nb, char* smem) {
  char* ws = P.ws;
  GArgs g = garg1((const bf16_t*)(ws + OFF_X1B), LD_XB, 1024, (const bf16_t*)(ws + OFF_WT_GU), LD_WGU);
  for (int t = bid; t < 64 * 44; t += nb) { int mt, nt; tile_mn(t, 44, mt, nt); gemm_tile<EPI_GU>(P, g, mt * 256, nt * 128, smem); }
}
__device__ void phase7(const Params& P, int bid, int nb, char* smem) {
  char* ws = P.ws;
  GArgs g = garg1((const bf16_t*)(ws + OFF_ACT), LD_ACT, 2816, (const bf16_t*)(ws + OFF_WT_DN), LD_WDN);
  for (int t = bid; t < 64 * 8; t += nb) { int mt, nt; tile_mn(t, 8, mt, nt); gemm_tile<EPI_DOWN>(P, g, mt * 256, nt * 128, smem); }
}


#define XB_TMO      128
#define XB_XCNT(j)  (256  + 64 * (j))
#define XB_XSUB(j)  (1280 + 64 * (j))
#define XB_XGEN(j)  (2304 + 64 * (j))
#define XB_TOP      3328
#define XB_TOPGEN   3392
#define XCD_BAR_WORDS 3456
#define XB_SPIN_CAP (1u << 18)
#define LAS __attribute__((address_space(3)))
DI unsigned xb_ld(unsigned* p) { return __hip_atomic_load(p, __ATOMIC_RELAXED, __HIP_MEMORY_SCOPE_AGENT); }
DI unsigned xb_add(unsigned* p, unsigned v) { return __hip_atomic_fetch_add(p, v, __ATOMIC_RELAXED, __HIP_MEMORY_SCOPE_AGENT); }
DI unsigned xb_xcc_id() { return (unsigned)__builtin_amdgcn_s_getreg((3 << 11) | 20) & 0xFu; }
#define XB_SPIN(cond, bar) do { unsigned _sp = 0; while (cond) { __builtin_amdgcn_s_sleep(1); \
    if ((++_sp & 255u) == 0u) { if (xb_ld(&(bar)[XB_TMO])) break; if (_sp > XB_SPIN_CAP) { atomicAdd(&(bar)[XB_TMO], 1u); break; } } } } while (0)
struct XcdBarrier { unsigned* bar; unsigned x; volatile LAS unsigned* st; };
DI XcdBarrier xcd_barrier_post(unsigned* bar, volatile LAS unsigned* st) {
  XcdBarrier b; b.bar = bar; b.x = xb_xcc_id(); b.st = st;
  if (threadIdx.x == 0) (void)xb_add(&bar[XB_XCNT(b.x)], 1u);
  return b;
}
DI void xcd_barrier_complete(unsigned* bar, unsigned x, unsigned& nloc, unsigned& nx) {
  const unsigned G = gridDim.x * gridDim.y * gridDim.z;
  unsigned sum, cnt, mine, sp = 0u;
  for (;;) {
    sum = 0u; cnt = 0u; mine = 0u;
#pragma unroll
    for (unsigned j = 0; j < 16; ++j) { const unsigned c = xb_ld(&bar[XB_XCNT(j)]); sum += c; cnt += (c > 0u) ? 1u : 0u; mine = (j == x) ? c : mine; }
    if (sum == G) break;
    __builtin_amdgcn_s_sleep(1);
    if ((++sp & 255u) == 0u) { if (xb_ld(&bar[XB_TMO])) break; if (sp > XB_SPIN_CAP) { atomicAdd(&bar[XB_TMO], 1u); break; } }
  }
  nloc = mine > 0u ? mine : 1u; nx = cnt > 0u ? cnt : 1u;
}
DI void xcd_barrier(const XcdBarrier& b) {
  asm volatile("s_waitcnt vmcnt(0)" ::: "memory");
  __syncthreads();
  if (threadIdx.x == 0) {
    unsigned* bar = b.bar;
    __builtin_amdgcn_s_waitcnt(0);
    unsigned nloc = b.st[0], nx = b.st[1];
    if (nloc == 0u) { xcd_barrier_complete(bar, b.x, nloc, nx); b.st[0] = nloc; b.st[1] = nx; }
    const unsigned old = xb_add(&bar[XB_XSUB(b.x)], 1u);
    const unsigned gen = old / nloc;
    if (old + 1u == (gen + 1u) * nloc) {
      __builtin_amdgcn_fence(__ATOMIC_RELEASE, "agent");
      asm volatile("s_waitcnt vmcnt(0)" ::: "memory");
      const unsigned og = xb_add(&bar[XB_TOP], 1u);
      const unsigned tg = og / nx;
      if (og + 1u == (tg + 1u) * nx) xb_add(&bar[XB_TOPGEN], 1u);
      else XB_SPIN(xb_ld(&bar[XB_TOPGEN]) == tg, bar);
      __builtin_amdgcn_fence(__ATOMIC_ACQUIRE, "agent");
      xb_add(&bar[XB_XGEN(b.x)], 1u);
      asm volatile("s_waitcnt vmcnt(0)" ::: "memory");
    } else {
      XB_SPIN(xb_ld(&bar[XB_XGEN(b.x)]) == gen, bar);
      __builtin_amdgcn_fence(__ATOMIC_ACQUIRE, "agent");
      asm volatile("s_waitcnt vmcnt(0)" ::: "memory");
    }
  }
  __syncthreads();
}

#if MEGA
__global__ void __launch_bounds__(256, 2) fwd_megakernel(Params P) {
  __shared__ __attribute__((aligned(16))) char smem[SMEM_BYTES];
  __shared__ uint4 xb_words;
  cg::grid_group grid = cg::this_grid();
  if (P.ws == nullptr) grid.sync();
  if (threadIdx.x == 0) xb_words = make_uint4(0u, 0u, 0u, 0u);
  __syncthreads();
  const XcdBarrier xb = xcd_barrier_post((unsigned*)(P.ws + OFF_BAR), (volatile LAS unsigned*)&xb_words);
  const int bid = blockIdx.x, nb = gridDim.x;
  phase0(P, bid, nb, smem); xcd_barrier(xb);
  phase1(P, bid, nb, smem); xcd_barrier(xb);
  phase2(P, bid, nb, smem); xcd_barrier(xb);
  phase3(P, bid, nb, smem); xcd_barrier(xb);
  phase4(P, smem); xcd_barrier(xb);
  phase5(P, bid, nb, smem); xcd_barrier(xb);
  phase6(P, bid, nb, smem); xcd_barrier(xb);
  phase7(P, bid, nb, smem);
}
#else
#define PHASE_KERNEL(NAME, CALL)                                             \
  __global__ void __launch_bounds__(256, 2) NAME(Params P) {                 \
    __shared__ __attribute__((aligned(16))) char smem[SMEM_BYTES];           \
    const int bid = blockIdx.x, nb = gridDim.x; (void)bid; (void)nb;         \
    CALL;                                                                    \
  }
PHASE_KERNEL(k_p0, phase0(P, bid, nb, smem))
PHASE_KERNEL(k_p1, phase1(P, bid, nb, smem))
PHASE_KERNEL(k_p2, phase2(P, bid, nb, smem))
PHASE_KERNEL(k_p3, phase3(P, bid, nb, smem))
PHASE_KERNEL(k_p4, phase4(P, smem))
PHASE_KERNEL(k_p5, phase5(P, bid, nb, smem))
PHASE_KERNEL(k_p6, phase6(P, bid, nb, smem))
PHASE_KERNEL(k_p7, phase7(P, bid, nb, smem))
#endif

extern "C" void kernel_launch(void* const* d_in, const int* in_sizes, int n_in, void* d_out, int out_size, void* d_ws,
                              size_t ws_size, hipStream_t stream) {
  Params p{};
  p.x = (const float*)d_in[0]; p.mem = (const float*)d_in[1]; p.pos = (const int*)d_in[2];
  p.norm_mix = (const float*)d_in[3]; p.norm_mem = (const float*)d_in[4]; p.w_in = (const float*)d_in[5];
  p.q_a_norm = (const float*)d_in[6]; p.w_uq = (const float*)d_in[7]; p.kv_a_norm = (const float*)d_in[8];
  p.w_ukv = (const float*)d_in[9]; p.mla_q_norm = (const float*)d_in[10]; p.mla_k_norm = (const float*)d_in[11];
  p.lb_logits = (const float*)d_in[12]; p.hg_out_norm = (const float*)d_in[13]; p.w_mem_kv = (const float*)d_in[14];
  p.mem_q_norm = (const float*)d_in[15]; p.mem_k_norm = (const float*)d_in[16]; p.mla_out_norm = (const float*)d_in[17];
  p.mem_out_norm = (const float*)d_in[18]; p.w_out = (const float*)d_in[19]; p.norm_ffn = (const float*)d_in[20];
  p.w_gate = (const float*)d_in[21]; p.w_up = (const float*)d_in[22]; p.w_down = (const float*)d_in[23];
  p.out = (float*)d_out; p.ws = (char*)d_ws;
  for (int i = 0; i < 32; ++i) p.inv_freq[i] = std::pow(10000.0, -(double)i / 32.0);
#if MEGA
  static int grid_blocks = 0;
  if (!grid_blocks) {
    int dev = 0, cus = 0, per_cu = 0;
    hipGetDevice(&dev);
    hipDeviceGetAttribute(&cus, hipDeviceAttributeMultiprocessorCount, dev);
    hipOccupancyMaxActiveBlocksPerMultiprocessor(&per_cu, fwd_megakernel, 256, 0);
    if (per_cu > 2) per_cu = 2;
    if (per_cu < 1) per_cu = 1;
    grid_blocks = cus * per_cu;
  }
  void* args[] = {&p};
  (void)hipMemsetAsync((char*)d_ws + OFF_BAR, 0, XCD_BAR_WORDS * sizeof(unsigned), stream);
  hipError_t e = hipLaunchCooperativeKernel((void*)fwd_megakernel, dim3(grid_blocks), dim3(256), args, 0, stream);
  if (e != hipSuccess) fprintf(stderr, "cooperative launch failed: %s (grid %d)\n", hipGetErrorString(e), grid_blocks);
#else
  const int G = 512;
  k_p0<<<G, 256, 0, stream>>>(p);
  k_p1<<<G, 256, 0, stream>>>(p);
  k_p2<<<G, 256, 0, stream>>>(p);
  k_p3<<<G, 256, 0, stream>>>(p);
  k_p4<<<G, 256, 0, stream>>>(p);
  k_p5<<<G, 256, 0, stream>>>(p);
  k_p6<<<G, 256, 0, stream>>>(p);
  k_p7<<<G, 256, 0, stream>>>(p);
#endif
}
```

```cpp
#include <hip/hip_runtime.h>
#include <hip/hip_cooperative_groups.h>
#include <stdint.h>
#include <cmath>
#include <cstdio>
namespace cg = cooperative_groups;

#ifndef MEGA
#define MEGA 1
#endif

typedef unsigned short bf16_t;
using bf16x8 = __attribute__((ext_vector_type(8))) short;
using f32x16 = __attribute__((ext_vector_type(16))) float;
#define DI __device__ __forceinline__
#define MFMA(a, b, c) __builtin_amdgcn_mfma_f32_32x32x16_bf16((a), (b), (c), 0, 0, 0)

constexpr int T_TOK = 16384, SEQ = 8192;
constexpr float EPS = 1e-6f;
constexpr float LOG2E = 1.4426950408889634f;

constexpr size_t MiB = 1ull << 20;
constexpr int LD_WIN = 1088, LD_WUQ = 448, LD_WUKV = 320, LD_WMKV = 1088, LD_WOUT = 1600, LD_WGU = 1088, LD_WDN = 2880;
constexpr int LD_XB = 1088, LD_PH = 2112, LD_PM = 576, LD_YMLA = 576, LD_VT = 8256, LD_ACT = 2880;
constexpr size_t OFF_WT_IN = 0;
constexpr size_t OFF_WT_UQ = OFF_WT_IN + 3328ull * LD_WIN * 2;
constexpr size_t OFF_WT_UKV = OFF_WT_UQ + 768ull * LD_WUQ * 2;
constexpr size_t OFF_WT_MKV = OFF_WT_UKV + 1024ull * LD_WUKV * 2;
constexpr size_t OFF_WT_OUT = OFF_WT_MKV + 1024ull * LD_WMKV * 2;
constexpr size_t OFF_WT_GU = OFF_WT_OUT + 1024ull * LD_WOUT * 2;
constexpr size_t OFF_WT_DN = OFF_WT_GU + 5632ull * LD_WGU * 2;
constexpr size_t OFF_WT_END = OFF_WT_DN + 1024ull * LD_WDN * 2;
constexpr size_t OFF_SMALL = 31 * MiB;
static_assert(OFF_WT_END <= OFF_SMALL, "weights overflow");
constexpr size_t OFF_R0 = OFF_SMALL;
constexpr size_t OFF_RM = OFF_R0 + 65536;
constexpr size_t OFF_LB = OFF_RM + 2048;
constexpr size_t OFF_CNT = OFF_LB + 2048;
constexpr size_t OFF_SS = OFF_CNT + 256;
constexpr size_t OFF_COS = OFF_SS + 3 * 65536;
constexpr size_t OFF_SIN = OFF_COS + 2 * MiB;
constexpr size_t OFF_MEMB = OFF_SIN + 2 * MiB;
constexpr size_t OFF_MEMKV = OFF_MEMB + 1 * MiB;
constexpr size_t OFF_KMEM = OFF_MEMKV + 2 * MiB;
constexpr size_t OFF_VMEMT = OFF_KMEM + 512 * 1024;
constexpr size_t OFF_DEC = OFF_VMEMT + 512 * 1024;
constexpr size_t OFF_BAR = OFF_DEC + 512 * 1024;
constexpr size_t OFF_SSL = OFF_BAR + 16384;
constexpr size_t OFF_PROJA = 40 * MiB;
static_assert(OFF_SSL + 2 * 65536 <= OFF_PROJA, "small region overflow (ssl)");
static_assert(OFF_BAR + 16384 <= OFF_PROJA, "small region overflow");
constexpr size_t OFF_YMLA = OFF_PROJA;
constexpr size_t OFF_XB = 62 * MiB;
constexpr size_t OFF_L = OFF_XB;
constexpr size_t OFF_PROJH = 96 * MiB;
constexpr size_t OFF_PROJM = 162 * MiB;
constexpr size_t OFF_Q = 180 * MiB;
constexpr size_t OFF_K = 204 * MiB;
constexpr size_t OFF_VT = 228 * MiB;
constexpr size_t OFF_X1B = OFF_Q;
constexpr size_t OFF_ACT = 40 * MiB;
static_assert(OFF_VT + 1024ull * LD_VT * 2 <= 256 * MiB, "ws overflow");

struct Params {
  const float* x; const float* mem; const int* pos;
  const float *norm_mix, *norm_mem, *w_in, *q_a_norm, *w_uq, *kv_a_norm, *w_ukv, *mla_q_norm, *mla_k_norm, *lb_logits,
      *hg_out_norm, *w_mem_kv, *mem_q_norm, *mem_k_norm, *mla_out_norm, *mem_out_norm, *w_out, *norm_ffn, *w_gate, *w_up, *w_down;
  float* out; char* ws;
  double inv_freq[32];
};

DI float bf2f(bf16_t b) { return __uint_as_float(((unsigned)b) << 16); }
typedef __bf16 bf2_t __attribute__((ext_vector_type(2)));
typedef float f2_t __attribute__((ext_vector_type(2)));
DI unsigned pack2(float a, float b) { f2_t v = {a, b}; return __builtin_bit_cast(unsigned, __builtin_convertvector(v, bf2_t)); }
DI bf16_t f2bf(float x) { return (bf16_t)(pack2(x, 0.f) & 0xffffu); }
DI float lo2f(unsigned u) { return __uint_as_float(u << 16); }
DI float hi2f(unsigned u) { return __uint_as_float(u & 0xffff0000u); }
DI int crow(int reg, int h) { return (reg & 3) + 8 * (reg >> 2) + 4 * h; }
DI float wave_sum(float v) {
  for (int o = 32; o >= 1; o >>= 1) v += __shfl_xor(v, o, 64);
  return v;
}
DI float sigmoidf_(float x) { return __builtin_amdgcn_rcpf(1.f + __expf(-x)); }
DI bf16x8 pack8(const f32x16& x, int s) {
  uint4 p;
  p.x = pack2(x[8 * s + 0], x[8 * s + 1]); p.y = pack2(x[8 * s + 2], x[8 * s + 3]);
  p.z = pack2(x[8 * s + 4], x[8 * s + 5]); p.w = pack2(x[8 * s + 6], x[8 * s + 7]);
  return __builtin_bit_cast(bf16x8, p);
}
DI f32x16 zero16() { f32x16 z; for (int i = 0; i < 16; ++i) z[i] = 0.f; return z; }

constexpr int SMEM_BYTES = 74752;

DI float wgain(const Params& P, int gmode, const float* g1, int k) {
  if (gmode == 0) return 1.f;
  if (gmode == 1) return g1[k];
  return k < 512 ? P.mla_out_norm[k] : (k < 1024 ? 1.f : P.mem_out_norm[k - 1024]);
}
__device__ void transpose_cvt_tile(const Params& P, const float* W, int N, const float* g1, int gmode, bf16_t* Wt, int ldt,
                                   int rowmode, int kt, int nt, char* smem) {
  float(*tile)[65] = (float(*)[65])smem;
  const int tid = threadIdx.x, k0 = kt * 64, n0 = nt * 64;
  for (int i = 0; i < 16; ++i) {
    int idx = tid + 256 * i, kk = idx >> 6, nn = idx & 63;
    float v = 0.f;
    if (n0 + nn < N) v = W[(size_t)(k0 + kk) * N + n0 + nn] * wgain(P, gmode, g1, k0 + kk);
    tile[kk][nn] = v;
  }
  __syncthreads();
  for (int i = 0; i < 16; ++i) {
    int idx = tid + 256 * i, nn = idx >> 6, kk = idx & 63;
    int n = n0 + nn;
    int dr = rowmode == 0 ? n : ((n >> 5) * 64 + (n & 31) + (rowmode == 2 ? 32 : 0));
    Wt[(size_t)dr * ldt + k0 + kk] = f2bf(tile[kk][nn]);
  }
  __syncthreads();
}

__device__ void prep_transpose_job(const Params& P, int j, char* smem) {
  char* ws = P.ws;
  if (j < 832) { transpose_cvt_tile(P, P.w_in, 3264, P.norm_mix, 1, (bf16_t*)(ws + OFF_WT_IN), LD_WIN, 0, j / 52, j % 52, smem); return; }
  j -= 832;
  if (j < 72) { transpose_cvt_tile(P, P.w_uq, 768, P.q_a_norm, 1, (bf16_t*)(ws + OFF_WT_UQ), LD_WUQ, 0, j / 12, j % 12, smem); return; }
  j -= 72;
  if (j < 64) { transpose_cvt_tile(P, P.w_ukv, 1024, P.kv_a_norm, 1, (bf16_t*)(ws + OFF_WT_UKV), LD_WUKV, 0, j / 16, j % 16, smem); return; }
  j -= 64;
  if (j < 256) { transpose_cvt_tile(P, P.w_mem_kv, 1024, P.norm_mem, 1, (bf16_t*)(ws + OFF_WT_MKV), LD_WMKV, 0, j / 16, j % 16, smem); return; }
  j -= 256;
  if (j < 384) { transpose_cvt_tile(P, P.w_out, 1024, nullptr, 2, (bf16_t*)(ws + OFF_WT_OUT), LD_WOUT, 0, j / 16, j % 16, smem); return; }
  j -= 384;
  if (j < 704) { transpose_cvt_tile(P, P.w_gate, 2816, P.norm_ffn, 1, (bf16_t*)(ws + OFF_WT_GU), LD_WGU, 1, j / 44, j % 44, smem); return; }
  j -= 704;
  if (j < 704) { transpose_cvt_tile(P, P.w_up, 2816, P.norm_ffn, 1, (bf16_t*)(ws + OFF_WT_GU), LD_WGU, 2, j / 44, j % 44, smem); return; }
  j -= 704;
  transpose_cvt_tile(P, P.w_down, 1024, nullptr, 0, (bf16_t*)(ws + OFF_WT_DN), LD_WDN, 0, j / 16, j % 16, smem);
}

__device__ void phase0(const Params& P, int bid, int nb, char* smem) {
  char* ws = P.ws;
  const int tid = threadIdx.x, lane = tid & 63, wave = tid >> 6;
  constexpr int J_TR = 1224, J_ROWS = 4224, J_TAB = 2048, J_ZERO = 320, J_LB = 2;
  constexpr int J_TOTAL = J_TR + J_ROWS + J_TAB + J_ZERO + J_LB;
  for (int job = bid; job < J_TOTAL; job += nb) {
    if (job < J_TR) { prep_transpose_job(P, job, smem); continue; }
    int j = job - J_TR;
    if (j < J_ROWS) {
      int row = j * 4 + wave;
      const float* src; bf16_t* dst; float* rdst;
      if (row < T_TOK) { src = P.x + (size_t)row * 1024; dst = (bf16_t*)(ws + OFF_XB) + (size_t)row * LD_XB; rdst = (float*)(ws + OFF_R0) + row; }
      else { int r2 = row - T_TOK; src = P.mem + (size_t)r2 * 1024; dst = (bf16_t*)(ws + OFF_MEMB) + (size_t)r2 * 1024; rdst = (float*)(ws + OFF_RM) + r2; }
      float ss = 0.f;
      float4 v[4];
      for (int i = 0; i < 4; ++i) { v[i] = *(const float4*)(src + (i * 64 + lane) * 4); ss += v[i].x * v[i].x + v[i].y * v[i].y + v[i].z * v[i].z + v[i].w * v[i].w; }
      ss = wave_sum(ss);
      for (int i = 0; i < 4; ++i) { uint2 o; o.x = pack2(v[i].x, v[i].y); o.y = pack2(v[i].z, v[i].w); *(uint2*)(dst + (i * 64 + lane) * 4) = o; }
      if (lane == 0) *rdst = rsqrtf(ss * (1.f / 1024.f) + EPS);
      continue;
    }
    j -= J_ROWS;
    if (j < J_TAB) {
      int idx = j * 256 + tid;
      int t = idx >> 5, i = idx & 31;
      double ang = (double)P.pos[t] * P.inv_freq[i];
      double rev = ang * 0.15915494309189535;
      double fr = rev - rint(rev);
      float f = (float)fr;
      ((float*)(ws + OFF_COS))[idx] = __builtin_amdgcn_cosf(f);
      ((float*)(ws + OFF_SIN))[idx] = __builtin_amdgcn_sinf(f);
      continue;
    }
    j -= J_TAB;
    if (j < J_ZERO) { if (j < 192) ((float*)(ws + OFF_SS))[j * 256 + tid] = 0.f; else ((float*)(ws + OFF_SSL))[(j - 192) * 256 + tid] = 0.f; continue; }
    j -= J_ZERO;
    {
      int c = j * 256 + tid;
      float l0 = P.lb_logits[c], l1 = P.lb_logits[512 + c];
      ((float*)(ws + OFF_LB))[c] = 1.f / (1.f + __expf(l1 - l0));
      if (c < 4) ((unsigned*)(ws + OFF_CNT))[c] = 0u;
    }
  }
}

enum { EPI_PROJ = 0, EPI_MEMKV, EPI_Q, EPI_KV, EPI_OUT, EPI_GU, EPI_DOWN };
constexpr int G_ROWB = 144;
constexpr int G_ATILE = 256 * G_ROWB;
constexpr int G_STAGE = 384 * G_ROWB;
constexpr int LDS_RS = G_STAGE;
constexpr int CW_LD = 68;
constexpr int CW_BYTES = 32 * CW_LD * 4;

struct GArgs {
  const bf16_t *A0, *A1, *A2; int lda0, lda1, lda2; int kb0, kb1, kb2;
  int segIters, nIter, Ktot;
  const bf16_t* Bt; int ldb;
};

template <int EPI>
__device__ __forceinline__ void gemm_tile(const Params& P, const GArgs& g, int m0, int n0, char* smem) {
  const int tid = threadIdx.x, lane = tid & 63, wave = tid >> 6, r = lane & 31, h = lane >> 5;
  const int wm = wave >> 1, wn = wave & 1;
  char* ws = P.ws;
  float* rs = (float*)(smem + LDS_RS);
  float* f3 = rs + 256;

  if (EPI == EPI_Q || EPI == EPI_KV) {
    const float ssv = ((const float*)(ws + OFF_SSL))[(EPI == EPI_KV ? T_TOK : 0) + m0 + tid];
    rs[tid] = rsqrtf(ssv / (float)g.Ktot + EPS);
  }
  if (EPI == EPI_PROJ) rs[tid] = ((const float*)(ws + OFF_R0))[m0 + tid];
  if (EPI == EPI_MEMKV) rs[tid] = ((const float*)(ws + OFF_RM))[m0 + tid];
  if (EPI == EPI_GU) rs[tid] = rsqrtf(((const float*)(ws + OFF_SS))[2 * T_TOK + m0 + tid] * (1.f / 1024.f) + EPS);
  if (EPI == EPI_OUT) {
    const float* ssb = (const float*)(ws + OFF_SS);
    float r1 = rsqrtf(ssb[m0 + tid] * (1.f / 512.f) + EPS);
    float r3 = rsqrtf(ssb[T_TOK + m0 + tid] * (1.f / 512.f) + EPS);
    rs[tid] = r1 / r3; f3[tid] = r3;
  }

  f32x16 acc[4][2];
#pragma unroll
  for (int i = 0; i < 4; ++i) { acc[i][0] = zero16(); acc[i][1] = zero16(); }

  typedef unsigned u32x4_t __attribute__((ext_vector_type(4)));
  u32x4_t ra0, ra1, ra2, ra3, ra4, ra5, ra6, ra7, rb0, rb1, rb2, rb3;
  const bf16_t* const gA0 = g.A0; const bf16_t* const gA1 = g.A1; const bf16_t* const gA2 = g.A2;
  const int glda0 = g.lda0, glda1 = g.lda1, glda2 = g.lda2, gkb0 = g.kb0, gkb1 = g.kb1, gkb2 = g.kb2;
  const int segIters = g.segIters, nIter = g.nIter, ldb = g.ldb;
  const bf16_t* const gBt = g.Bt;
  const int lrow = tid >> 3, lkc = tid & 7;
#define GM_GLD(dst, voff, sbase) asm volatile("global_load_dwordx4 %0, %1, %2" : "=v"(dst) : "v"(voff), "s"(sbase) : "memory")
#define GM_LOADG(it_)                                                                   \
  {                                                                                     \
    const int seg_ = ((it_) >= segIters) + ((it_) >= 2 * segIters);                     \
    const int kk_ = ((it_) - seg_ * segIters) * 64;                                     \
    const bf16_t* Ap_ = gA0; int lda_ = glda0, kb_ = gkb0;                              \
    if (seg_ == 1) { Ap_ = gA1; lda_ = glda1; kb_ = gkb1; }                             \
    if (seg_ == 2) { Ap_ = gA2; lda_ = glda2; kb_ = gkb2; }                             \
    const bf16_t* ab_ = Ap_ + (size_t)m0 * lda_ + kk_;                                  \
    const bf16_t* bb_ = gBt + (size_t)n0 * ldb + kb_ + kk_;                             \
    const unsigned oa_ = (unsigned)(lrow * lda_ + lkc * 8) * 2u, sa2_ = (unsigned)lda_ * 64u; \
    const unsigned ob_ = (unsigned)(lrow * ldb + lkc * 8) * 2u, sb2_ = (unsigned)ldb * 64u;   \
    GM_GLD(ra0, oa_, ab_); GM_GLD(ra1, oa_ + sa2_, ab_); GM_GLD(ra2, oa_ + 2u * sa2_, ab_); GM_GLD(ra3, oa_ + 3u * sa2_, ab_); \
    GM_GLD(ra4, oa_ + 4u * sa2_, ab_); GM_GLD(ra5, oa_ + 5u * sa2_, ab_); GM_GLD(ra6, oa_ + 6u * sa2_, ab_); GM_GLD(ra7, oa_ + 7u * sa2_, ab_); \
    GM_GLD(rb0, ob_, bb_); GM_GLD(rb1, ob_ + sb2_, bb_); GM_GLD(rb2, ob_ + 2u * sb2_, bb_); GM_GLD(rb3, ob_ + 3u * sb2_, bb_); \
  }
#define GM_WAIT0()                                                                      \
  asm volatile("s_waitcnt vmcnt(0)"                                                     \
               : "+v"(ra0), "+v"(ra1), "+v"(ra2), "+v"(ra3), "+v"(ra4), "+v"(ra5), "+v"(ra6), "+v"(ra7),     \
                 "+v"(rb0), "+v"(rb1), "+v"(rb2), "+v"(rb3) : : "memory")
#define GM_STOREL()                                                                     \
  {                                                                                     \
    char* sa_ = smem + lrow * G_ROWB + lkc * 16;                                        \
    char* sb_ = sa_ + G_ATILE;                                                          \
    *(u32x4_t*)(sa_) = ra0; *(u32x4_t*)(sa_ + 32 * G_ROWB) = ra1;                       \
    *(u32x4_t*)(sa_ + 64 * G_ROWB) = ra2; *(u32x4_t*)(sa_ + 96 * G_ROWB) = ra3;         \
    *(u32x4_t*)(sa_ + 128 * G_ROWB) = ra4; *(u32x4_t*)(sa_ + 160 * G_ROWB) = ra5;       \
    *(u32x4_t*)(sa_ + 192 * G_ROWB) = ra6; *(u32x4_t*)(sa_ + 224 * G_ROWB) = ra7;       \
    *(u32x4_t*)(sb_) = rb0; *(u32x4_t*)(sb_ + 32 * G_ROWB) = rb1;                       \
    *(u32x4_t*)(sb_ + 64 * G_ROWB) = rb2; *(u32x4_t*)(sb_ + 96 * G_ROWB) = rb3;         \
  }
#define GM_COMPUTE()                                                                    \
  {                                                                                     \
    const char* sa_ = smem + (wm * 128 + r) * G_ROWB + h * 16;                          \
    const char* sb_ = smem + G_ATILE + (wn * 64 + r) * G_ROWB + h * 16;                 \
    _Pragma("unroll") for (int ks = 0; ks < 4; ++ks) {                                  \
      bf16x8 b0 = *(const bf16x8*)(sb_ + ks * 32);                                      \
      bf16x8 b1 = *(const bf16x8*)(sb_ + 32 * G_ROWB + ks * 32);                        \
      _Pragma("unroll") for (int i = 0; i < 4; ++i) {                                   \
        bf16x8 a = *(const bf16x8*)(sa_ + i * 32 * G_ROWB + ks * 32);                   \
        acc[i][0] = MFMA(a, b0, acc[i][0]);                                             \
        acc[i][1] = MFMA(a, b1, acc[i][1]);                                             \
      }                                                                                 \
    }                                                                                   \
  }

  GM_LOADG(0);
  GM_WAIT0();
  GM_STOREL();
  __syncthreads();
  if (nIter > 1) GM_LOADG(1);
#pragma unroll 1
  for (int it = 0; it < nIter; ++it) {
    if (EPI == EPI_OUT) {
      if (it == segIters || it == 2 * segIters) {
        const float* fac = (it == segIters) ? rs : f3;
#pragma unroll
        for (int i = 0; i < 4; ++i)
#pragma unroll
          for (int q = 0; q < 16; ++q) {
            float f = fac[wm * 128 + i * 32 + crow(q, h)];
            acc[i][0][q] *= f; acc[i][1][q] *= f;
          }
      }
    }
    __builtin_amdgcn_s_setprio(1);
    GM_COMPUTE();
    __builtin_amdgcn_s_setprio(0);
    __syncthreads();
    if (it + 1 < nIter) {
      GM_WAIT0();
      GM_STOREL();
    }
    __syncthreads();
    if (it + 2 < nIter) GM_LOADG(it + 2);
  }

  float* Cw = (float*)(smem + wave * CW_BYTES);
  const int ncol0 = n0 + wn * 64;
#pragma unroll
  for (int i = 0; i < 4; ++i) {
    const int mrow0 = wm * 128 + i * 32;
#pragma unroll
    for (int j = 0; j < 2; ++j)
#pragma unroll
      for (int q = 0; q < 16; ++q) Cw[crow(q, h) * CW_LD + j * 32 + r] = acc[i][j][q];
    __builtin_amdgcn_fence(__ATOMIC_RELEASE, "wavefront");
    if (EPI == EPI_KV && ((ncol0 >> 7) & 1)) {
      const int hh = ncol0 >> 8, c = (ncol0 & 127) + lane;
      const int b = m0 >> 13, s0 = (m0 & (SEQ - 1)) + mrow0;
      bf16_t* vt = (bf16_t*)(ws + OFF_VT) + (((size_t)((b * 4 + hh) * 128 + (s0 >> 6))) * 128 + c) * 64 + (s0 & 63);
#pragma unroll
      for (int g8 = 0; g8 < 4; ++g8) {
        float v[8];
#pragma unroll
        for (int k = 0; k < 8; ++k) v[k] = Cw[(g8 * 8 + k) * CW_LD + lane] * rs[mrow0 + g8 * 8 + k];
        uint4 o; o.x = pack2(v[0], v[1]); o.y = pack2(v[2], v[3]); o.z = pack2(v[4], v[5]); o.w = pack2(v[6], v[7]);
        *(uint4*)(vt + g8 * 8) = o;
      }
    } else if (EPI == EPI_GU) {
      const int L8 = lane & 7, rs8 = lane >> 3;
#pragma unroll 2
      for (int p = 0; p < 4; ++p) {
        const int row = p * 8 + rs8, m = m0 + mrow0 + row;
        float4 v0 = *(const float4*)(Cw + row * CW_LD + 4 * L8);
        float4 v1 = *(const float4*)(Cw + row * CW_LD + 32 + 4 * L8);
        float s = rs[mrow0 + row];
        float gx[4] = {v0.x * s, v0.y * s, v0.z * s, v0.w * s};
        float ux[4] = {v1.x * s, v1.y * s, v1.z * s, v1.w * s};
        float a[4];
#pragma unroll
        for (int q = 0; q < 4; ++q) a[q] = gx[q] * sigmoidf_(gx[q]) * ux[q];
        uint2 u; u.x = pack2(a[0], a[1]); u.y = pack2(a[2], a[3]);
        *(uint2*)((bf16_t*)(ws + OFF_ACT) + (size_t)m * LD_ACT + (ncol0 >> 1) + 4 * L8) = u;
      }
    } else {
      const int L = lane & 15, rsub = lane >> 4;
      constexpr int UNR_ = (EPI == EPI_OUT || EPI == EPI_DOWN) ? 4 : 2;
#pragma clang loop unroll_count(UNR_)
      for (int p = 0; p < 8; ++p) {
        const int row = p * 4 + rsub, trow = mrow0 + row, m = m0 + trow;
        const int n = ncol0 + 4 * L;
        float4 v = *(const float4*)(Cw + row * CW_LD + 4 * L);
        if (EPI == EPI_PROJ) {
          float s = rs[trow];
          uint2 o; o.x = pack2(v.x * s, v.y * s); o.y = pack2(v.z * s, v.w * s);
          if (n < 704) *(uint2*)((bf16_t*)(ws + OFF_PROJA) + (size_t)m * 704 + n) = o;
          else if (n < 2752) *(uint2*)((bf16_t*)(ws + OFF_PROJH) + (size_t)m * LD_PH + (n - 704)) = o;
          else if (n < 3264) *(uint2*)((bf16_t*)(ws + OFF_PROJM) + (size_t)m * LD_PM + (n - 2752)) = o;
          if (ncol0 < 640) {
            float q0_ = lo2f(o.x), q1_ = hi2f(o.x), q2_ = lo2f(o.y), q3_ = hi2f(o.y);
            float ssq = q0_ * q0_ + q1_ * q1_ + q2_ * q2_ + q3_ * q3_;
            ssq += __shfl_xor(ssq, 1, 64); ssq += __shfl_xor(ssq, 2, 64); ssq += __shfl_xor(ssq, 4, 64); ssq += __shfl_xor(ssq, 8, 64);
            if (L == 0) atomicAdd((float*)(ws + OFF_SSL) + (ncol0 < 384 ? 0 : T_TOK) + m, ssq);
          }
        } else if (EPI == EPI_MEMKV) {
          float s = rs[trow];
          *(float4*)((float*)(ws + OFF_MEMKV) + (size_t)m * 1024 + n) = make_float4(v.x * s, v.y * s, v.z * s, v.w * s);
        } else if (EPI == EPI_Q) {
          float s = rs[trow];
          uint2 u; u.x = pack2(v.x * s, v.y * s); u.y = pack2(v.z * s, v.w * s);
          *(uint2*)((bf16_t*)(ws + OFF_Q) + (size_t)m * 768 + n) = u;
        } else if (EPI == EPI_KV) {
          float s = rs[trow];
          uint2 u; u.x = pack2(v.x * s, v.y * s); u.y = pack2(v.z * s, v.w * s);
          *(uint2*)((bf16_t*)(ws + OFF_K) + ((size_t)((m >> 13) * 4 + (n >> 8)) * SEQ + (m & (SEQ - 1))) * 192 + (n & 127)) = u;
        } else if (EPI == EPI_OUT) {
          float4 xin = *(const float4*)(P.x + (size_t)m * 1024 + n);
          float4 o = make_float4(xin.x + v.x, xin.y + v.y, xin.z + v.z, xin.w + v.w);
          *(float4*)(P.out + (size_t)m * 1024 + n) = o;
          uint2 u; u.x = pack2(o.x, o.y); u.y = pack2(o.z, o.w);
          *(uint2*)((bf16_t*)(ws + OFF_X1B) + (size_t)m * LD_XB + n) = u;
          float ssq = o.x * o.x + o.y * o.y + o.z * o.z + o.w * o.w;
          ssq += __shfl_xor(ssq, 1, 64); ssq += __shfl_xor(ssq, 2, 64); ssq += __shfl_xor(ssq, 4, 64); ssq += __shfl_xor(ssq, 8, 64);
          if (L == 0) atomicAdd((float*)(ws + OFF_SS) + 2 * T_TOK + m, ssq);
        } else if (EPI == EPI_DOWN) {
          float4 xin = *(const float4*)(P.out + (size_t)m * 1024 + n);
          *(float4*)(P.out + (size_t)m * 1024 + n) = make_float4(xin.x + v.x, xin.y + v.y, xin.z + v.z, xin.w + v.w);
        }
      }
    }
    __builtin_amdgcn_fence(__ATOMIC_ACQUIRE, "wavefront");
  }
  __syncthreads();
}

DI GArgs garg1(const bf16_t* A, int lda, int K, const bf16_t* Bt, int ldb) {
  GArgs g;
  g.A0 = g.A1 = g.A2 = A; g.lda0 = g.lda1 = g.lda2 = lda; g.kb0 = g.kb1 = g.kb2 = 0;
  g.segIters = K / 64; g.nIter = K / 64; g.Ktot = K; g.Bt = Bt; g.ldb = ldb;
  return g;
}

DI void tile_mn(int t, int NT, int& mt, int& nt) {
  int grp = t / (32 * NT), rem = t - grp * 32 * NT;
  nt = rem >> 5; mt = grp * 32 + (rem & 31);
}

__device__ void phase1(const Params& P, int bid, int nb, char* smem) {
  char* ws = P.ws;
  GArgs g1 = garg1((const bf16_t*)(ws + OFF_XB), LD_XB, 1024, (const bf16_t*)(ws + OFF_WT_IN), LD_WIN);
  GArgs g2 = garg1((const bf16_t*)(ws + OFF_MEMB), 1024, 1024, (const bf16_t*)(ws + OFF_WT_MKV), LD_WMKV);
  constexpr int NT1 = 64 * 26;
  for (int t = bid; t < NT1 + 16; t += nb) {
    if (t < NT1) { int mt, nt; tile_mn(t, 26, mt, nt); gemm_tile<EPI_PROJ>(P, g1, mt * 256, nt * 128, smem); }
    else { int u = t - NT1; gemm_tile<EPI_MEMKV>(P, g2, (u & 1) * 256, (u >> 1) * 128, smem); }
  }
  {
    const int rem = (NT1 + 16) % nb;
    const int first = rem == 0 ? 0 : rem, stride = nb - first;
    if (bid >= first)
      for (int u = bid - first; u < 2496; u += stride) prep_transpose_job(P, 1224 + u, smem);
  }
}

constexpr int VT_ROWB = 144;
constexpr int QK_ROWB = 272;
DI void hg_tile_to_lds(const bf16_t* src, char* dst) {
  const int tid = threadIdx.x;
  uint4 v0, v1, v2, v3;
  {
    const int t = tid >> 4, dc = tid & 15;
    const bf16_t* p = src + (size_t)t * LD_PH + dc * 8;
    v0 = *(const uint4*)(p); v1 = *(const uint4*)(p + (size_t)16 * LD_PH);
    v2 = *(const uint4*)(p + (size_t)32 * LD_PH); v3 = *(const uint4*)(p + (size_t)48 * LD_PH);
    char* d = dst + t * QK_ROWB + dc * 16;
    *(uint4*)(d) = v0; *(uint4*)(d + 16 * QK_ROWB) = v1; *(uint4*)(d + 32 * QK_ROWB) = v2; *(uint4*)(d + 48 * QK_ROWB) = v3;
  }
}
DI void hg_build_vT(const bf16_t* src, char* svT) {
  const int tid = threadIdx.x;
  const int t = tid & 63, dc0 = tid >> 6;
  uint4 v0, v1, v2, v3;
  const bf16_t* p = src + (size_t)t * LD_PH + dc0 * 8;
  v0 = *(const uint4*)(p); v1 = *(const uint4*)(p + 32); v2 = *(const uint4*)(p + 64); v3 = *(const uint4*)(p + 96);
#define HG_SCATTER(v, i)                                                        \
  {                                                                             \
    char* d = svT + ((dc0 + 4 * (i)) * 8) * VT_ROWB + t * 2;                    \
    *(bf16_t*)(d) = (bf16_t)(v.x & 0xffff); *(bf16_t*)(d + VT_ROWB) = (bf16_t)(v.x >> 16);             \
    *(bf16_t*)(d + 2 * VT_ROWB) = (bf16_t)(v.y & 0xffff); *(bf16_t*)(d + 3 * VT_ROWB) = (bf16_t)(v.y >> 16); \
    *(bf16_t*)(d + 4 * VT_ROWB) = (bf16_t)(v.z & 0xffff); *(bf16_t*)(d + 5 * VT_ROWB) = (bf16_t)(v.z >> 16); \
    *(bf16_t*)(d + 6 * VT_ROWB) = (bf16_t)(v.w & 0xffff); *(bf16_t*)(d + 7 * VT_ROWB) = (bf16_t)(v.w >> 16); \
  }
  HG_SCATTER(v0, 0) HG_SCATTER(v1, 1) HG_SCATTER(v2, 2) HG_SCATTER(v3, 3)
}

__device__ void hg_local_state(const Params& P, int item, char* smem) {
  char* ws = P.ws;
  const int tid = threadIdx.x, lane = tid & 63, wave = tid >> 6, r = lane & 31, h = lane >> 5;
  const int bh = item >> 7, c = item & 127, b = bh >> 2, hh = bh & 3;
  const int t0 = b * SEQ + c * 64;
  char* svT = smem;
  char* skT = smem + 128 * VT_ROWB;
  char* sraw = smem + 256 * VT_ROWB;
  const bf16_t* src = (const bf16_t*)(ws + OFF_PROJH) + (size_t)t0 * LD_PH + hh * 128;
  hg_tile_to_lds(src + 512, sraw);
  hg_build_vT(src + 1024, svT);
  __syncthreads();
  if (tid < 128) {
    const int d = tid;
    const float lb = ((const float*)(ws + OFF_LB))[hh * 128 + d];
    float run = 0.f;
    for (int j = 7; j >= 0; --j) {
      float v[8];
#pragma unroll
      for (int i = 7; i >= 0; --i) {
        float f = lb + (1.f - lb) * sigmoidf_(bf2f(*(const bf16_t*)(sraw + (8 * j + i) * QK_ROWB + d * 2)));
        v[i] = (1.f - f) * __builtin_amdgcn_exp2f(run);
        run += __builtin_amdgcn_logf(f);
      }
      uint4 o; o.x = pack2(v[0], v[1]); o.y = pack2(v[2], v[3]); o.z = pack2(v[4], v[5]); o.w = pack2(v[6], v[7]);
      *(uint4*)(skT + d * VT_ROWB + j * 16) = o;
    }
    ((float*)(ws + OFF_DEC))[(size_t)(bh * 128 + c) * 128 + d] = __builtin_amdgcn_exp2f(run);
  }
  __syncthreads();
  f32x16 acc[4];
  for (int i = 0; i < 4; ++i) acc[i] = zero16();
#pragma unroll
  for (int ks = 0; ks < 4; ++ks) {
    bf16x8 a = *(const bf16x8*)(svT + (wave * 32 + r) * VT_ROWB + ks * 32 + h * 16);
#pragma unroll
    for (int dt = 0; dt < 4; ++dt) {
      bf16x8 bb = *(const bf16x8*)(skT + (dt * 32 + r) * VT_ROWB + ks * 32 + h * 16);
      acc[dt] = MFMA(a, bb, acc[dt]);
    }
  }
  bf16_t* L = (bf16_t*)(ws + OFF_L) + (size_t)(bh * 128 + c) * 16384;
#pragma unroll
  for (int dt = 0; dt < 4; ++dt)
#pragma unroll
    for (int q = 0; q < 16; ++q) L[(wave * 32 + crow(q, h)) * 128 + dt * 32 + r] = f2bf(acc[dt][q]);
  __syncthreads();
}

__device__ void phase2(const Params& P, int bid, int nb, char* smem) {
  char* ws = P.ws;
  GArgs gq = garg1((const bf16_t*)(ws + OFF_PROJA), 704, 384, (const bf16_t*)(ws + OFF_WT_UQ), LD_WUQ);
  GArgs gkv = garg1((const bf16_t*)(ws + OFF_PROJA) + 384, 704, 256, (const bf16_t*)(ws + OFF_WT_UKV), LD_WUKV);
  constexpr int NQ = 64 * 6, NKV = 64 * 8, NH = 1024;
  for (int t = bid; t < NQ + NKV + NH; t += nb) {
    if (t < NQ) { int mt, nt; tile_mn(t, 6, mt, nt); gemm_tile<EPI_Q>(P, gq, mt * 256, nt * 128, smem); }
    else if (t < NQ + NKV) { int mt, nt; tile_mn(t - NQ, 8, mt, nt); gemm_tile<EPI_KV>(P, gkv, mt * 256, nt * 128, smem); }
    else hg_local_state(P, t - NQ - NKV, smem);
  }
}

__device__ void phase3(const Params& P, int bid, int nb, char* smem) {
  char* ws = P.ws;
  const int tid = threadIdx.x, lane = tid & 63, wave = tid >> 6;
  constexpr int J_SCAN = 512, J_NORM = 4096, J_MEMK = 128;
  for (int job = bid; job < J_SCAN + J_NORM + J_MEMK; job += nb) {
    if (job < J_SCAN) {
      int idx = job * 256 + tid;
      int d = idx & 127, e = (idx >> 7) & 127, bh = idx >> 14;
      bf16_t* L = (bf16_t*)(ws + OFF_L) + (size_t)bh * 128 * 16384 + e * 128 + d;
      const float* dec = (const float*)(ws + OFF_DEC) + (size_t)bh * 128 * 128 + d;
      float S = 0.f;
      float tA[16], dA[16], tB[16], dB[16];
#pragma unroll
      for (int i = 0; i < 16; ++i) { tA[i] = bf2f(L[(size_t)i * 16384]); dA[i] = dec[i * 128]; }
#pragma unroll 1
      for (int c0 = 0; c0 < 128; c0 += 32) {
#pragma unroll
        for (int i = 0; i < 16; ++i) { tB[i] = bf2f(L[(size_t)(c0 + 16 + i) * 16384]); dB[i] = dec[(c0 + 16 + i) * 128]; }
#pragma unroll
        for (int i = 0; i < 16; ++i) { L[(size_t)(c0 + i) * 16384] = f2bf(S); S = dA[i] * S + tA[i]; }
        if (c0 + 32 < 128) {
#pragma unroll
          for (int i = 0; i < 16; ++i) { tA[i] = bf2f(L[(size_t)(c0 + 32 + i) * 16384]); dA[i] = dec[(c0 + 32 + i) * 128]; }
        }
#pragma unroll
        for (int i = 0; i < 16; ++i) { L[(size_t)(c0 + 16 + i) * 16384] = f2bf(S); S = dB[i] * S + tB[i]; }
      }
      continue;
    }
    int j = job - J_SCAN;
    if (j < J_NORM) {
      const int t = j * 4 + wave;
      const float cs = ((const float*)(ws + OFF_COS))[t * 32 + (lane & 31)];
      const float sn = ((const float*)(ws + OFF_SIN))[t * 32 + (lane & 31)];
      const float sgn = lane < 32 ? -1.f : 1.f;
      const float qscale = 0.07216878364870322f * LOG2E;
      bf16_t* Q = (bf16_t*)(ws + OFF_Q) + (size_t)t * 768;
      bf16_t* K = (bf16_t*)(ws + OFF_K) + ((size_t)((t >> 13) * 4) * SEQ + (t & (SEQ - 1))) * 192;
      const float kr = bf2f(((const bf16_t*)(ws + OFF_PROJA))[(size_t)t * 704 + 640 + lane]);
      const float gq0 = P.mla_q_norm[lane], gq1 = P.mla_q_norm[64 + lane], gq2 = P.mla_q_norm[128 + lane];
      const float gk0 = P.mla_k_norm[lane], gk1 = P.mla_k_norm[64 + lane], gk2 = P.mla_k_norm[128 + lane];
      bf16_t* M = (bf16_t*)(ws + OFF_PROJM) + (size_t)t * LD_PM;
      const float gm0 = P.mem_q_norm[lane], gm1 = P.mem_q_norm[64 + lane];
      float qv[4][3], kv[4][2], mv[4][2];
#pragma unroll
      for (int hh = 0; hh < 4; ++hh) {
        qv[hh][0] = bf2f(Q[hh * 192 + lane]); qv[hh][1] = bf2f(Q[hh * 192 + 64 + lane]); qv[hh][2] = bf2f(Q[hh * 192 + 128 + lane]);
        kv[hh][0] = bf2f(K[(size_t)hh * SEQ * 192 + lane]); kv[hh][1] = bf2f(K[(size_t)hh * SEQ * 192 + 64 + lane]);
        mv[hh][0] = bf2f(M[hh * 128 + lane]); mv[hh][1] = bf2f(M[hh * 128 + 64 + lane]);
      }
      float sq[4], sk[4], sm[4];
#pragma unroll
      for (int hh = 0; hh < 4; ++hh) {
        sq[hh] = qv[hh][0] * qv[hh][0] + qv[hh][1] * qv[hh][1] + qv[hh][2] * qv[hh][2];
        sk[hh] = kv[hh][0] * kv[hh][0] + kv[hh][1] * kv[hh][1] + kr * kr;
        sm[hh] = mv[hh][0] * mv[hh][0] + mv[hh][1] * mv[hh][1];
      }
#pragma unroll
      for (int o = 32; o >= 1; o >>= 1) {
#pragma unroll
        for (int hh = 0; hh < 4; ++hh) {
          sq[hh] += __shfl_xor(sq[hh], o, 64); sk[hh] += __shfl_xor(sk[hh], o, 64); sm[hh] += __shfl_xor(sm[hh], o, 64);
        }
      }
#pragma unroll
      for (int hh = 0; hh < 4; ++hh) {
        {
          float rstd = rsqrtf(sq[hh] * (1.f / 192.f) + EPS);
          float n0 = qv[hh][0] * rstd * gq0, n1 = qv[hh][1] * rstd * gq1, n2 = qv[hh][2] * rstd * gq2;
          float pr = __shfl_xor(n2, 32, 64);
          float ro = n2 * cs + sgn * pr * sn;
          Q[hh * 192 + lane] = f2bf(n0 * qscale); Q[hh * 192 + 64 + lane] = f2bf(n1 * qscale); Q[hh * 192 + 128 + lane] = f2bf(ro * qscale);
        }
        {
          float rstd = rsqrtf(sk[hh] * (1.f / 192.f) + EPS);
          float n0 = kv[hh][0] * rstd * gk0, n1 = kv[hh][1] * rstd * gk1, n2 = kr * rstd * gk2;
          float pr = __shfl_xor(n2, 32, 64);
          float ro = n2 * cs + sgn * pr * sn;
          K[(size_t)hh * SEQ * 192 + lane] = f2bf(n0); K[(size_t)hh * SEQ * 192 + 64 + lane] = f2bf(n1); K[(size_t)hh * SEQ * 192 + 128 + lane] = f2bf(ro);
        }
        {
          float rstd = rsqrtf(sm[hh] * (1.f / 128.f) + EPS) * (0.08838834764831845f * LOG2E);
          M[hh * 128 + lane] = f2bf(mv[hh][0] * rstd * gm0); M[hh * 128 + 64 + lane] = f2bf(mv[hh][1] * rstd * gm1);
        }
      }
      continue;
    }
    j -= J_NORM;
    {
      const int m = j * 4 + wave;
      const int b = m >> 8, key = m & 255;
      const float* src = (const float*)(ws + OFF_MEMKV) + (size_t)m * 1024;
      for (int hh = 0; hh < 4; ++hh) {
        float v0 = src[hh * 128 + lane], v1 = src[hh * 128 + 64 + lane];
        float ss = wave_sum(v0 * v0 + v1 * v1);
        float rstd = rsqrtf(ss * (1.f / 128.f) + EPS);
        bf16_t* km = (bf16_t*)(ws + OFF_KMEM) + ((size_t)((b * 4 + hh) * 256 + key)) * 128;
        km[lane] = f2bf(v0 * rstd * P.mem_k_norm[lane]); km[64 + lane] = f2bf(v1 * rstd * P.mem_k_norm[64 + lane]);
        bf16_t* vm = (bf16_t*)(ws + OFF_VMEMT) + ((size_t)(b * 4 + hh) * 128) * 256 + key;
        vm[(size_t)lane * 256] = f2bf(src[512 + hh * 128 + lane]);
        vm[(size_t)(64 + lane) * 256] = f2bf(src[512 + hh * 128 + 64 + lane]);
      }
    }
  }
}

constexpr int AV_ROWB = 136;
template <int DQK, bool CAUSAL>
__device__ __forceinline__ void attn_item(const bf16_t* Q, int ldq, const bf16_t* K, int ldk, const bf16_t* Vt, int ldv, int vts, int q0, int nkeys,
                          bf16_t* Y, int ldy, float* ssout, char* smem) {
  constexpr int KROWB = (DQK + 8) * 2;
  constexpr int KCH = DQK / 8;
  constexpr int NKL = (64 * KCH) / 256;
  constexpr int NKS = DQK / 16;
  int tid = threadIdx.x;
  asm volatile("" : "+v"(tid));
  const int lane = tid & 63, wave = tid >> 6, r = lane & 31, h = lane >> 5;
  const int rg = wave & 1, kh = wave >> 1;
  char* sK = smem;
  char* sV = smem + 64 * KROWB;
  const int qrow = q0 + rg * 32 + r;

  char* sQ = smem + 64 * KROWB + 128 * AV_ROWB;
  f32x16 oacc[4];
  for (int i = 0; i < 4; ++i) oacc[i] = zero16();
  float m_run = -INFINITY, l_run = 0.f;
  const int ntiles = CAUSAL ? (q0 + 64) / 64 : nkeys / 64;

  uint4 rk0, rk1, rk2, rk3, rk4, rk5, rv0, rv1, rv2, rv3;
  rk4 = make_uint4(0, 0, 0, 0); rk5 = rk4;
#define AT_KOFF(i) ((unsigned)(((tid + 256 * (i)) / KCH) * ldk + ((tid + 256 * (i)) % KCH) * 8) * 2u)
#define AT_VOFF(i) ((unsigned)(((tid + 256 * (i)) >> 3) * ldv + ((tid + 256 * (i)) & 7) * 8) * 2u)
#define AT_KLDS(i) (sK + ((tid + 256 * (i)) / KCH) * KROWB + ((tid + 256 * (i)) % KCH) * 16)
#define AT_VLDS(i) (sV + ((tid + 256 * (i)) >> 3) * AV_ROWB + ((tid + 256 * (i)) & 7) * 16)
#define AT_LOADG(kt_)                                                                   \
  {                                                                                     \
    const char* kb_ = (const char*)(K + (size_t)(kt_) * 64 * ldk);                      \
    const char* vb_ = (const char*)(Vt + (size_t)(kt_) * vts);                          \
    rk0 = *(const uint4*)(kb_ + AT_KOFF(0)); rk1 = *(const uint4*)(kb_ + AT_KOFF(1));   \
    rk2 = *(const uint4*)(kb_ + AT_KOFF(2)); rk3 = *(const uint4*)(kb_ + AT_KOFF(3));   \
    if (NKL > 4) { rk4 = *(const uint4*)(kb_ + AT_KOFF(4)); rk5 = *(const uint4*)(kb_ + AT_KOFF(5)); } \
    rv0 = *(const uint4*)(vb_ + AT_VOFF(0)); rv1 = *(const uint4*)(vb_ + AT_VOFF(1));   \
    rv2 = *(const uint4*)(vb_ + AT_VOFF(2)); rv3 = *(const uint4*)(vb_ + AT_VOFF(3));   \
  }
#define AT_VST(i, v)                                                    \
  {                                                                     \
    *(uint2*)(AT_VLDS(i)) = make_uint2(v.x, v.y);                       \
    *(uint2*)(AT_VLDS(i) + 8) = make_uint2(v.z, v.w);                   \
  }
#define AT_STOREL()                                                                     \
  {                                                                                     \
    *(uint4*)(AT_KLDS(0)) = rk0; *(uint4*)(AT_KLDS(1)) = rk1;                           \
    *(uint4*)(AT_KLDS(2)) = rk2; *(uint4*)(AT_KLDS(3)) = rk3;                           \
    if (NKL > 4) { *(uint4*)(AT_KLDS(4)) = rk4; *(uint4*)(AT_KLDS(5)) = rk5; }          \
    AT_VST(0, rv0) AT_VST(1, rv1) AT_VST(2, rv2) AT_VST(3, rv3)                         \
  }

  AT_LOADG(0);
  for (int c = tid; c < 64 * KCH; c += 256) {
    const int row = c / KCH, kc = c - row * KCH;
    *(uint4*)(sQ + row * KROWB + kc * 16) = *(const uint4*)(Q + (size_t)(q0 + row) * ldq + kc * 8);
  }

  AT_STOREL();
  __syncthreads();
  constexpr int NQR = NKS / 2;
  bf16x8 qh[NQR];
#pragma unroll
  for (int ks = 0; ks < NQR; ++ks) qh[ks] = *(const bf16x8*)(sQ + (rg * 32 + r) * KROWB + ks * 32 + h * 16);
  for (int kt = 0; kt < ntiles; ++kt) {
    if (kt + 1 < ntiles) AT_LOADG(kt + 1);
    __builtin_amdgcn_sched_barrier(0);
    const int k0 = kt * 64 + kh * 32;
    f32x16 sc = zero16();
    __builtin_amdgcn_s_setprio(1);
#pragma unroll
    for (int ks = 0; ks < NKS; ++ks) {
      bf16x8 a0 = *(const bf16x8*)(sK + (kh * 32 + r) * KROWB + ks * 32 + h * 16);
      bf16x8 bq;
      if (ks < NQR) bq = qh[ks < NQR ? ks : 0]; else bq = *(const bf16x8*)(sQ + (rg * 32 + r) * KROWB + ks * 32 + h * 16);
      sc = MFMA(a0, bq, sc);

    }
    if (CAUSAL) {
      if (k0 + 31 > q0 + rg * 32) {
#pragma unroll
        for (int q = 0; q < 16; ++q) {
          int key = k0 + crow(q, h);
          if (key > qrow) sc[q] = -INFINITY;
        }
      }
    }
    float mx = sc[0];
#pragma unroll
    for (int q = 1; q < 16; ++q) mx = fmaxf(mx, sc[q]);
    {
      auto sw = __builtin_amdgcn_permlane32_swap(__float_as_uint(mx), __float_as_uint(mx), false, false);
      mx = fmaxf(__uint_as_float(sw[0]), __uint_as_float(sw[1]));
    }
    if (__builtin_amdgcn_ballot_w64(mx > m_run + 8.f) != 0ull) {
      const float m_new = fmaxf(m_run, mx);
      const float m_safe = (m_new == -INFINITY) ? 0.f : m_new;
      const float alpha = __builtin_amdgcn_exp2f(m_run - m_safe);
      m_run = m_new;
      l_run *= alpha;
#pragma unroll
      for (int dt = 0; dt < 4; ++dt)
#pragma unroll
        for (int q = 0; q < 16; ++q) oacc[dt][q] *= alpha;
    }
    const float m_ref = (m_run == -INFINITY) ? 0.f : m_run;
    float ls = 0.f;
#pragma unroll
    for (int q = 0; q < 16; ++q) { sc[q] = __builtin_amdgcn_exp2f(sc[q] - m_ref); ls += sc[q]; }
    l_run += ls;
#pragma unroll
    for (int s2 = 0; s2 < 2; ++s2) {
      bf16x8 pb = pack8(sc, s2);
#pragma unroll
      for (int dt = 0; dt < 4; ++dt) {
        const char* vp = sV + (dt * 32 + r) * AV_ROWB + (32 * kh + 16 * s2 + 4 * h) * 2;
        uint2 lo = *(const uint2*)vp;
        uint2 hi = *(const uint2*)(vp + 16);
        uint4 av = make_uint4(lo.x, lo.y, hi.x, hi.y);
        oacc[dt] = MFMA(__builtin_bit_cast(bf16x8, av), pb, oacc[dt]);
      }
      __builtin_amdgcn_sched_barrier(0);
    }
    __builtin_amdgcn_s_setprio(0);
    __syncthreads();
    if (kt + 1 < ntiles) { AT_STOREL(); }
    __syncthreads();
  }
  float* mO = (float*)smem + rg * (66 * 64);
  if (kh == 1) {
#pragma unroll
    for (int dt = 0; dt < 4; ++dt)
#pragma unroll
      for (int q = 0; q < 16; ++q) mO[(dt * 16 + q) * 64 + lane] = oacc[dt][q];
    mO[64 * 64 + lane] = m_run;
    mO[65 * 64 + lane] = l_run;
  }
  __syncthreads();
  if (kh == 0) {
    const float m_b = mO[64 * 64 + lane], l_b = mO[65 * 64 + lane];
    const float m = fmaxf(m_run, m_b);
    const float fa = __builtin_amdgcn_exp2f(m_run - m), fb = __builtin_amdgcn_exp2f(m_b - m);
    float lsum = l_run * fa + l_b * fb;
    lsum += __shfl_xor(lsum, 32, 64);
    const float inv = 1.f / lsum;
    const float ca = fa * inv, cb = fb * inv;
    float ssq = 0.f;
#pragma unroll
    for (int dt = 0; dt < 4; ++dt)
#pragma unroll
      for (int g4 = 0; g4 < 4; ++g4) {
        float o0 = oacc[dt][4 * g4] * ca + mO[(dt * 16 + 4 * g4) * 64 + lane] * cb;
        float o1 = oacc[dt][4 * g4 + 1] * ca + mO[(dt * 16 + 4 * g4 + 1) * 64 + lane] * cb;
        float o2 = oacc[dt][4 * g4 + 2] * ca + mO[(dt * 16 + 4 * g4 + 2) * 64 + lane] * cb;
        float o3 = oacc[dt][4 * g4 + 3] * ca + mO[(dt * 16 + 4 * g4 + 3) * 64 + lane] * cb;
        ssq += o0 * o0 + o1 * o1 + o2 * o2 + o3 * o3;
        uint2 u; u.x = pack2(o0, o1); u.y = pack2(o2, o3);
        *(uint2*)(Y + (size_t)qrow * ldy + dt * 32 + 8 * g4 + 4 * h) = u;
      }
    ssq += __shfl_xor(ssq, 32, 64);
    if (h == 0) atomicAdd(ssout + qrow, ssq);
  }
  __syncthreads();
}

template <int DQK, bool CAUSAL>
__device__ __forceinline__ void attn_item128(const bf16_t* Q, int ldq, const bf16_t* K, int ldk, const bf16_t* Vt, int ldv, int vts,
                                          int q0, int kt0, int kt1, bf16_t* Y, int ldy, float* ssout, char* smem) {
  constexpr int KROWB = (DQK + 8) * 2;
  constexpr int KCH = DQK / 8;
  constexpr int NKL = (64 * KCH) / 256;
  constexpr int NKS = DQK / 16;
  int tid = threadIdx.x;
  asm volatile("" : "+v"(tid));
  const int lane = tid & 63, wave = tid >> 6, r = lane & 31, h = lane >> 5;
  char* sK = smem;
  char* sV = smem + 64 * KROWB;
  const int qrow = q0 + wave * 32 + r;

  bf16x8 qf[NKS];
#pragma unroll
  for (int ks = 0; ks < NKS; ++ks) qf[ks] = *(const bf16x8*)(Q + (size_t)qrow * ldq + ks * 16 + h * 8);

  f32x16 oacc[4];
  for (int i = 0; i < 4; ++i) oacc[i] = zero16();
  float m_run = -INFINITY, l_run = 0.f;

  uint4 rk0, rk1, rk2, rk3, rk4, rk5, rv0, rv1, rv2, rv3;
  rk4 = make_uint4(0, 0, 0, 0); rk5 = rk4;
#define BAT_KOFF(i) ((unsigned)(((tid + 256 * (i)) / KCH) * ldk + ((tid + 256 * (i)) % KCH) * 8) * 2u)
#define BAT_VOFF(i) ((unsigned)(((tid + 256 * (i)) >> 3) * ldv + ((tid + 256 * (i)) & 7) * 8) * 2u)
#define BAT_KLDS(i) (sK + ((tid + 256 * (i)) / KCH) * KROWB + ((tid + 256 * (i)) % KCH) * 16)
#define BAT_VLDS(i) (sV + ((tid + 256 * (i)) >> 3) * AV_ROWB + ((tid + 256 * (i)) & 7) * 16)
#define BAT_LOADG(kt_)                                                                   \
  {                                                                                     \
    const char* kb_ = (const char*)(K + (size_t)(kt_) * 64 * ldk);                      \
    const char* vb_ = (const char*)(Vt + (size_t)(kt_) * vts);                          \
    rk0 = *(const uint4*)(kb_ + BAT_KOFF(0)); rk1 = *(const uint4*)(kb_ + BAT_KOFF(1));   \
    rk2 = *(const uint4*)(kb_ + BAT_KOFF(2)); rk3 = *(const uint4*)(kb_ + BAT_KOFF(3));   \
    if (NKL > 4) { rk4 = *(const uint4*)(kb_ + BAT_KOFF(4)); rk5 = *(const uint4*)(kb_ + BAT_KOFF(5)); } \
    rv0 = *(const uint4*)(vb_ + BAT_VOFF(0)); rv1 = *(const uint4*)(vb_ + BAT_VOFF(1));   \
    rv2 = *(const uint4*)(vb_ + BAT_VOFF(2)); rv3 = *(const uint4*)(vb_ + BAT_VOFF(3));   \
  }
#define BAT_VST(i, v)                                                    \
  {                                                                     \
    *(uint2*)(BAT_VLDS(i)) = make_uint2(v.x, v.y);                       \
    *(uint2*)(BAT_VLDS(i) + 8) = make_uint2(v.z, v.w);                   \
  }
#define BAT_STOREL()                                                                     \
  {                                                                                     \
    *(uint4*)(BAT_KLDS(0)) = rk0; *(uint4*)(BAT_KLDS(1)) = rk1;                           \
    *(uint4*)(BAT_KLDS(2)) = rk2; *(uint4*)(BAT_KLDS(3)) = rk3;                           \
    if (NKL > 4) { *(uint4*)(BAT_KLDS(4)) = rk4; *(uint4*)(BAT_KLDS(5)) = rk5; }          \
    BAT_VST(0, rv0) BAT_VST(1, rv1) BAT_VST(2, rv2) BAT_VST(3, rv3)                         \
  }

  BAT_LOADG(kt0);
  BAT_STOREL();
  __syncthreads();
  for (int kt = kt0; kt < kt1; ++kt) {
    if (kt + 1 < kt1) BAT_LOADG(kt + 1);
    __builtin_amdgcn_sched_barrier(0);
    __builtin_amdgcn_s_setprio(1);
#pragma unroll
    for (int kh = 0; kh < 2; ++kh) {
      const int k0 = kt * 64 + kh * 32;
      f32x16 sc = zero16();
#pragma unroll
      for (int ks = 0; ks < NKS; ++ks) {
        bf16x8 a0 = *(const bf16x8*)(sK + (kh * 32 + r) * KROWB + ks * 32 + h * 16);
        sc = MFMA(a0, qf[ks], sc);
      }
      if (CAUSAL) {
        if (k0 + 31 > q0 + wave * 32) {
#pragma unroll
          for (int q = 0; q < 16; ++q) {
            int key = k0 + crow(q, h);
            if (key > qrow) sc[q] = -INFINITY;
          }
        }
      }
      float mx = sc[0];
#pragma unroll
      for (int q = 1; q < 16; ++q) mx = fmaxf(mx, sc[q]);
      {
        auto sw = __builtin_amdgcn_permlane32_swap(__float_as_uint(mx), __float_as_uint(mx), false, false);
        mx = fmaxf(__uint_as_float(sw[0]), __uint_as_float(sw[1]));
      }
      if (__builtin_amdgcn_ballot_w64(mx > m_run + 8.f) != 0ull) {
        const float m_new = fmaxf(m_run, mx);
        const float m_safe = (m_new == -INFINITY) ? 0.f : m_new;
        const float alpha = __builtin_amdgcn_exp2f(m_run - m_safe);
        m_run = m_new;
        l_run *= alpha;
#pragma unroll
        for (int dt = 0; dt < 4; ++dt)
#pragma unroll
          for (int q = 0; q < 16; ++q) oacc[dt][q] *= alpha;
      }
      const float m_ref = (m_run == -INFINITY) ? 0.f : m_run;
      float ls = 0.f;
#pragma unroll
      for (int q = 0; q < 16; ++q) { sc[q] = __builtin_amdgcn_exp2f(sc[q] - m_ref); ls += sc[q]; }
      l_run += ls;
#pragma unroll
      for (int s2 = 0; s2 < 2; ++s2) {
        bf16x8 pb = pack8(sc, s2);
#pragma unroll
        for (int dt = 0; dt < 4; ++dt) {
          const char* vp = sV + (dt * 32 + r) * AV_ROWB + (32 * kh + 16 * s2 + 4 * h) * 2;
          uint2 lo = *(const uint2*)vp;
          uint2 hi = *(const uint2*)(vp + 16);
          uint4 av = make_uint4(lo.x, lo.y, hi.x, hi.y);
          oacc[dt] = MFMA(__builtin_bit_cast(bf16x8, av), pb, oacc[dt]);
        }
      }
      __builtin_amdgcn_sched_barrier(0);
    }
    __builtin_amdgcn_s_setprio(0);
    __syncthreads();
    if (kt + 1 < kt1) { BAT_STOREL(); }
    __syncthreads();
  }
  const float l = l_run + __shfl_xor(l_run, 32, 64);
  const float ca = 1.f / l;
  float ssq = 0.f;
#pragma unroll
  for (int dt = 0; dt < 4; ++dt)
#pragma unroll
    for (int g4 = 0; g4 < 4; ++g4) {
      float o0 = oacc[dt][4 * g4] * ca, o1 = oacc[dt][4 * g4 + 1] * ca, o2 = oacc[dt][4 * g4 + 2] * ca, o3 = oacc[dt][4 * g4 + 3] * ca;
      ssq += o0 * o0 + o1 * o1 + o2 * o2 + o3 * o3;
      uint2 u; u.x = pack2(o0, o1); u.y = pack2(o2, o3);
      *(uint2*)(Y + (size_t)qrow * ldy + dt * 32 + 8 * g4 + 4 * h) = u;
    }
  ssq += __shfl_xor(ssq, 32, 64);
  if (h == 0) atomicAdd(ssout + qrow, ssq);
}

__device__ void hg_output(const Params& P, int item, char* smem) {
  char* ws = P.ws;
  const int tid = threadIdx.x, lane = tid & 63, wave = tid >> 6, r = lane & 31, h = lane >> 5;
  const int bh = item >> 7, c = item & 127, b = bh >> 2, hh = bh & 3;
  const int t0 = b * SEQ + c * 64;
  char* sq = smem;
  char* sk = smem + 64 * QK_ROWB;
  char* svT = smem + 128 * QK_ROWB;
  float* ssum = (float*)(smem + 128 * QK_ROWB + 128 * VT_ROWB);
  {
    const bf16_t* src = (const bf16_t*)(ws + OFF_PROJH) + (size_t)t0 * LD_PH + hh * 128;
    hg_tile_to_lds(src, sq);
    hg_tile_to_lds(src + 512, sk);
    hg_build_vT(src + 1024, svT);
  }
  __syncthreads();
  if (tid < 128) {
    const int d = tid;
    const float lb = ((const float*)(ws + OFF_LB))[hh * 128 + d];
    float bc = 0.f;
    for (int t8 = 0; t8 < 64; t8 += 8) {
      float qv[8], fv[8];
#pragma unroll
      for (int i = 0; i < 8; ++i) {
        qv[i] = bf2f(*(const bf16_t*)(sq + (t8 + i) * QK_ROWB + d * 2));
        fv[i] = bf2f(*(const bf16_t*)(sk + (t8 + i) * QK_ROWB + d * 2));
      }
#pragma unroll
      for (int i = 0; i < 8; ++i) {
        float f = lb + (1.f - lb) * sigmoidf_(fv[i]);
        bc += __builtin_amdgcn_logf(f);
        float qs = qv[i] * sigmoidf_(qv[i]) * 0.08838834764831845f * __builtin_amdgcn_exp2f(bc);
        float kx = (1.f - f) * __builtin_amdgcn_exp2f(-bc);
        *(bf16_t*)(sq + (t8 + i) * QK_ROWB + d * 2) = f2bf(qs);
        *(bf16_t*)(sk + (t8 + i) * QK_ROWB + d * 2) = f2bf(kx);
      }
    }
  }
  __syncthreads();
  const int tt = wave & 1, eh = wave >> 1;
  f32x16 x0 = zero16(), x1 = zero16();
#pragma unroll
  for (int ks = 0; ks < 8; ++ks) {
    bf16x8 bq = *(const bf16x8*)(sq + (tt * 32 + r) * QK_ROWB + ks * 32 + h * 16);
    bf16x8 a0 = *(const bf16x8*)(sk + r * QK_ROWB + ks * 32 + h * 16);
    x0 = MFMA(a0, bq, x0);
    if (tt == 1) {
      bf16x8 a1 = *(const bf16x8*)(sk + (32 + r) * QK_ROWB + ks * 32 + h * 16);
      x1 = MFMA(a1, bq, x1);
    }
  }
  if (tt == 0) {
#pragma unroll
    for (int q = 0; q < 16; ++q) if (crow(q, h) > r) x0[q] = 0.f;
  } else {
#pragma unroll
    for (int q = 0; q < 16; ++q) if (crow(q, h) > r) x1[q] = 0.f;
  }
  f32x16 o[2];
  o[0] = zero16(); o[1] = zero16();
  const int nst = (tt == 0) ? 2 : 4;
#pragma unroll
  for (int s = 0; s < 4; ++s) {
    if (s < nst) {
      bf16x8 pb = (s < 2) ? pack8(x0, s & 1) : pack8(x1, s & 1);
#pragma unroll
      for (int et = 0; et < 2; ++et) {
        const char* vp = svT + ((eh * 2 + et) * 32 + r) * VT_ROWB + (16 * s + 4 * h) * 2;
        uint2 lo = *(const uint2*)vp;
        uint2 hi = *(const uint2*)(vp + 16);
        uint4 av = make_uint4(lo.x, lo.y, hi.x, hi.y);
        o[et] = MFMA(__builtin_bit_cast(bf16x8, av), pb, o[et]);
      }
    }
  }
  const bf16_t* St = (const bf16_t*)(ws + OFF_L) + (size_t)(bh * 128 + c) * 16384;
#pragma unroll
  for (int ks = 0; ks < 8; ++ks) {
    bf16x8 bq = *(const bf16x8*)(sq + (tt * 32 + r) * QK_ROWB + ks * 32 + h * 16);
#pragma unroll
    for (int et = 0; et < 2; ++et) {
      bf16x8 a = *(const bf16x8*)(St + ((eh * 2 + et) * 32 + r) * 128 + ks * 16 + h * 8);
      o[et] = MFMA(a, bq, o[et]);
    }
  }
  float ssq = 0.f;
#pragma unroll
  for (int et = 0; et < 2; ++et)
#pragma unroll
    for (int q = 0; q < 16; ++q) ssq += o[et][q] * o[et][q];
  ssq += __shfl_xor(ssq, 32, 64);
  if (h == 0) ssum[eh * 64 + tt * 32 + r] = ssq;
  __syncthreads();
  const float tot = ssum[tt * 32 + r] + ssum[64 + tt * 32 + r];
  const float rstd = rsqrtf(tot * (1.f / 128.f) + EPS);
  bf16_t* gp = (bf16_t*)(ws + OFF_PROJH) + (size_t)(t0 + tt * 32 + r) * LD_PH + 1536 + hh * 128;
#pragma unroll
  for (int et = 0; et < 2; ++et)
#pragma unroll
    for (int g4 = 0; g4 < 4; ++g4) {
      const int e = (eh * 2 + et) * 32 + 8 * g4 + 4 * h;
      uint2 gu = *(const uint2*)(gp + e);
      float4 gn = *(const float4*)(P.hg_out_norm + hh * 128 + e);
      float g0 = lo2f(gu.x), g1 = hi2f(gu.x), g2 = lo2f(gu.y), g3 = hi2f(gu.y);
      float y0 = o[et][4 * g4] * rstd * gn.x * g0 * sigmoidf_(g0);
      float y1 = o[et][4 * g4 + 1] * rstd * gn.y * g1 * sigmoidf_(g1);
      float y2 = o[et][4 * g4 + 2] * rstd * gn.z * g2 * sigmoidf_(g2);
      float y3 = o[et][4 * g4 + 3] * rstd * gn.w * g3 * sigmoidf_(g3);
      uint2 u; u.x = pack2(y0, y1); u.y = pack2(y2, y3);
      *(uint2*)(gp + e) = u;
    }
  __syncthreads();
}

DI int next_item(unsigned* cnt, int* s_item) {
  if (threadIdx.x == 0) *s_item = (int)atomicAdd(cnt, 1u);
  __syncthreads();
  const int item = *s_item;
  __syncthreads();
  return item;
}
__device__ void phase4(const Params& P, char* smem) {
  char* ws = P.ws;
  __shared__ int s_item;
  unsigned* cnt = (unsigned*)(ws + OFF_CNT);
  constexpr int N_MLA = 1024, N_MEM = 1024, N_H3 = 1024;
  while (true) {
    const int item = next_item(cnt, &s_item);
    if (item >= N_MLA) break;
    const int qt = 127 - (item >> 3), bh = item & 7, b = bh >> 2, hh = bh & 3;
    attn_item<192, true>((const bf16_t*)(ws + OFF_Q) + (size_t)b * SEQ * 768 + hh * 192, 768,
                         (const bf16_t*)(ws + OFF_K) + (size_t)bh * SEQ * 192, 192,
                         (const bf16_t*)(ws + OFF_VT) + (size_t)bh * 128 * 8192, 64, 8192, qt * 64, 0,
                         (bf16_t*)(ws + OFF_YMLA) + (size_t)b * SEQ * LD_YMLA + hh * 128, LD_YMLA,
                         (float*)(ws + OFF_SS) + b * SEQ, smem);
  }
  while (true) {
    const int u = next_item(cnt + 1, &s_item);
    if (u >= N_MEM / 2) break;
    const int bh = u & 7, qt = u >> 3, b = bh >> 2, hh = bh & 3;
    bf16_t* qp = (bf16_t*)(ws + OFF_PROJM) + (size_t)b * SEQ * LD_PM + hh * 128;
    attn_item128<128, false>(qp, LD_PM, (const bf16_t*)(ws + OFF_KMEM) + (size_t)bh * 256 * 128, 128,
                             (const bf16_t*)(ws + OFF_VMEMT) + (size_t)bh * 128 * 256, 256, 64, qt * 128, 0, 4, qp, LD_PM,
                             (float*)(ws + OFF_SS) + T_TOK + b * SEQ, smem);
  }
  while (true) {
    const int u = next_item(cnt + 2, &s_item);
    if (u >= N_H3) break;
    hg_output(P, u, smem);
  }
}

__device__ void phase5(const Params& P, int bid, int nb, char* smem) {
  char* ws = P.ws;
  GArgs g;
  g.A0 = (const bf16_t*)(ws + OFF_YMLA); g.lda0 = LD_YMLA; g.kb0 = 0;
  g.A1 = (const bf16_t*)(ws + OFF_PROJM); g.lda1 = LD_PM; g.kb1 = 1024;
  g.A2 = (const bf16_t*)(ws + OFF_PROJH) + 1536; g.lda2 = LD_PH; g.kb2 = 512;
  g.segIters = 8; g.nIter = 24; g.Ktot = 1536; g.Bt = (const bf16_t*)(ws + OFF_WT_OUT); g.ldb = LD_WOUT;
  for (int t = bid; t < 64 * 8; t += nb) { int mt, nt; tile_mn(t, 8, mt, nt); gemm_tile<EPI_OUT>(P, g, mt * 256, nt * 128, smem); }
}
__device__ void phase6(const Params& P, int bid, int nb, char* smem) {
  char* ws = P.ws;
  GArgs g = garg1((const bf16_t*)(ws + OFF_X1B), LD_XB, 1024, (const bf16_t*)(ws + OFF_WT_GU), LD_WGU);
  for (int t = bid; t < 64 * 44; t += nb) { int mt, nt; tile_mn(t, 44, mt, nt); gemm_tile<EPI_GU>(P, g, mt * 256, nt * 128, smem); }
}
__device__ void phase7(const Params& P, int bid, int nb, char* smem) {
  char* ws = P.ws;
  GArgs g = garg1((const bf16_t*)(ws + OFF_ACT), LD_ACT, 2816, (const bf16_t*)(ws + OFF_WT_DN), LD_WDN);
  for (int t = bid; t < 64 * 8; t += nb) { int mt, nt; tile_mn(t, 8, mt, nt); gemm_tile<EPI_DOWN>(P, g, mt * 256, nt * 128, smem); }
}


#define XB_TMO      128
#define XB_XCNT(j)  (256  + 64 * (j))
#define XB_XSUB(j)  (1280 + 64 * (j))
#define XB_XGEN(j)  (2304 + 64 * (j))
#define XB_TOP      3328
#define XB_TOPGEN   3392
#define XCD_BAR_WORDS 3456
#define XB_SPIN_CAP (1u << 18)
#define LAS __attribute__((address_space(3)))
DI unsigned xb_ld(unsigned* p) { return __hip_atomic_load(p, __ATOMIC_RELAXED, __HIP_MEMORY_SCOPE_AGENT); }
DI unsigned xb_add(unsigned* p, unsigned v) { return __hip_atomic_fetch_add(p, v, __ATOMIC_RELAXED, __HIP_MEMORY_SCOPE_AGENT); }
DI unsigned xb_xcc_id() { return (unsigned)__builtin_amdgcn_s_getreg((3 << 11) | 20) & 0xFu; }
#define XB_SPIN(cond, bar) do { unsigned _sp = 0; while (cond) { __builtin_amdgcn_s_sleep(1); \
    if ((++_sp & 255u) == 0u) { if (xb_ld(&(bar)[XB_TMO])) break; if (_sp > XB_SPIN_CAP) { atomicAdd(&(bar)[XB_TMO], 1u); break; } } } } while (0)
struct XcdBarrier { unsigned* bar; unsigned x; volatile LAS unsigned* st; };
DI XcdBarrier xcd_barrier_post(unsigned* bar, volatile LAS unsigned* st) {
  XcdBarrier b; b.bar = bar; b.x = xb_xcc_id(); b.st = st;
  if (threadIdx.x == 0) (void)xb_add(&bar[XB_XCNT(b.x)], 1u);
  return b;
}
DI void xcd_barrier_complete(unsigned* bar, unsigned x, unsigned& nloc, unsigned& nx) {
  const unsigned G = gridDim.x * gridDim.y * gridDim.z;
  unsigned sum, cnt, mine, sp = 0u;
  for (;;) {
    sum = 0u; cnt = 0u; mine = 0u;
#pragma unroll
    for (unsigned j = 0; j < 16; ++j) { const unsigned c = xb_ld(&bar[XB_XCNT(j)]); sum += c; cnt += (c > 0u) ? 1u : 0u; mine = (j == x) ? c : mine; }
    if (sum == G) break;
    __builtin_amdgcn_s_sleep(1);
    if ((++sp & 255u) == 0u) { if (xb_ld(&bar[XB_TMO])) break; if (sp > XB_SPIN_CAP) { atomicAdd(&bar[XB_TMO], 1u); break; } }
  }
  nloc = mine > 0u ? mine : 1u; nx = cnt > 0u ? cnt : 1u;
}
DI void xcd_barrier(const XcdBarrier& b) {
  asm volatile("s_waitcnt vmcnt(0)" ::: "memory");
  __syncthreads();
  if (threadIdx.x == 0) {
    unsigned* bar = b.bar;
    __builtin_amdgcn_s_waitcnt(0);
    unsigned nloc = b.st[0], nx = b.st[1];
    if (nloc == 0u) { xcd_barrier_complete(bar, b.x, nloc, nx); b.st[0] = nloc; b.st[1] = nx; }
    const unsigned old = xb_add(&bar[XB_XSUB(b.x)], 1u);
    const unsigned gen = old / nloc;
    if (old + 1u == (gen + 1u) * nloc) {
      __builtin_amdgcn_fence(__ATOMIC_RELEASE, "agent");
      asm volatile("s_waitcnt vmcnt(0)" ::: "memory");
      const unsigned og = xb_add(&bar[XB_TOP], 1u);
      const unsigned tg = og / nx;
      if (og + 1u == (tg + 1u) * nx) xb_add(&bar[XB_TOPGEN], 1u);
      else XB_SPIN(xb_ld(&bar[XB_TOPGEN]) == tg, bar);
      __builtin_amdgcn_fence(__ATOMIC_ACQUIRE, "agent");
      xb_add(&bar[XB_XGEN(b.x)], 1u);
      asm volatile("s_waitcnt vmcnt(0)" ::: "memory");
    } else {
      XB_SPIN(xb_ld(&bar[XB_XGEN(b.x)]) == gen, bar);
      __builtin_amdgcn_fence(__ATOMIC_ACQUIRE, "agent");
      asm volatile("s_waitcnt vmcnt(0)" ::: "memory");
    }
  }
  __syncthreads();
}

#if MEGA
__global__ void __launch_bounds__(256, 2) fwd_megakernel(Params P) {
  __shared__ __attribute__((aligned(16))) char smem[SMEM_BYTES];
  __shared__ uint4 xb_words;
  cg::grid_group grid = cg::this_grid();
  if (P.ws == nullptr) grid.sync();
  if (threadIdx.x == 0) xb_words = make_uint4(0u, 0u, 0u, 0u);
  __syncthreads();
  const XcdBarrier xb = xcd_barrier_post((unsigned*)(P.ws + OFF_BAR), (volatile LAS unsigned*)&xb_words);
  const int bid = blockIdx.x, nb = gridDim.x;
  phase0(P, bid, nb, smem); xcd_barrier(xb);
  phase1(P, bid, nb, smem); xcd_barrier(xb);
  phase2(P, bid, nb, smem); xcd_barrier(xb);
  phase3(P, bid, nb, smem); xcd_barrier(xb);
  phase4(P, smem); xcd_barrier(xb);
  phase5(P, bid, nb, smem); xcd_barrier(xb);
  phase6(P, bid, nb, smem); xcd_barrier(xb);
  phase7(P, bid, nb, smem);
}
#else
#define PHASE_KERNEL(NAME, CALL)                                             \
  __global__ void __launch_bounds__(256, 2) NAME(Params P) {                 \
    __shared__ __attribute__((aligned(16))) char smem[SMEM_BYTES];           \
    const int bid = blockIdx.x, nb = gridDim.x; (void)bid; (void)nb;         \
    CALL;                                                                    \
  }
PHASE_KERNEL(k_p0, phase0(P, bid, nb, smem))
PHASE_KERNEL(k_p1, phase1(P, bid, nb, smem))
PHASE_KERNEL(k_p2, phase2(P, bid, nb, smem))
PHASE_KERNEL(k_p3, phase3(P, bid, nb, smem))
PHASE_KERNEL(k_p4, phase4(P, smem))
PHASE_KERNEL(k_p5, phase5(P, bid, nb, smem))
PHASE_KERNEL(k_p6, phase6(P, bid, nb, smem))
PHASE_KERNEL(k_p7, phase7(P, bid, nb, smem))
#endif

extern "C" void kernel_launch(void* const* d_in, const int* in_sizes, int n_in, void* d_out, int out_size, void* d_ws,
                              size_t ws_size, hipStream_t stream) {
  Params p{};
  p.x = (const float*)d_in[0]; p.mem = (const float*)d_in[1]; p.pos = (const int*)d_in[2];
  p.norm_mix = (const float*)d_in[3]; p.norm_mem = (const float*)d_in[4]; p.w_in = (const float*)d_in[5];
  p.q_a_norm = (const float*)d_in[6]; p.w_uq = (const float*)d_in[7]; p.kv_a_norm = (const float*)d_in[8];
  p.w_ukv = (const float*)d_in[9]; p.mla_q_norm = (const float*)d_in[10]; p.mla_k_norm = (const float*)d_in[11];
  p.lb_logits = (const float*)d_in[12]; p.hg_out_norm = (const float*)d_in[13]; p.w_mem_kv = (const float*)d_in[14];
  p.mem_q_norm = (const float*)d_in[15]; p.mem_k_norm = (const float*)d_in[16]; p.mla_out_norm = (const float*)d_in[17];
  p.mem_out_norm = (const float*)d_in[18]; p.w_out = (const float*)d_in[19]; p.norm_ffn = (const float*)d_in[20];
  p.w_gate = (const float*)d_in[21]; p.w_up = (const float*)d_in[22]; p.w_down = (const float*)d_in[23];
  p.out = (float*)d_out; p.ws = (char*)d_ws;
  for (int i = 0; i < 32; ++i) p.inv_freq[i] = std::pow(10000.0, -(double)i / 32.0);
#if MEGA
  static int grid_blocks = 0;
  if (!grid_blocks) {
    int dev = 0, cus = 0, per_cu = 0;
    hipGetDevice(&dev);
    hipDeviceGetAttribute(&cus, hipDeviceAttributeMultiprocessorCount, dev);
    hipOccupancyMaxActiveBlocksPerMultiprocessor(&per_cu, fwd_megakernel, 256, 0);
    if (per_cu > 2) per_cu = 2;
    if (per_cu < 1) per_cu = 1;
    grid_blocks = cus * per_cu;
  }
  void* args[] = {&p};
  (void)hipMemsetAsync((char*)d_ws + OFF_BAR, 0, XCD_BAR_WORDS * sizeof(unsigned), stream);
  hipError_t e = hipLaunchCooperativeKernel((void*)fwd_megakernel, dim3(grid_blocks), dim3(256), args, 0, stream);
  if (e != hipSuccess) fprintf(stderr, "cooperative launch failed: %s (grid %d)\n", hipGetErrorString(e), grid_blocks);
#else
  const int G = 512;
  k_p0<<<G, 256, 0, stream>>>(p);
  k_p1<<<G, 256, 0, stream>>>(p);
  k_p2<<<G, 256, 0, stream>>>(p);
  k_p3<<<G, 256, 0, stream>>>(p);
  k_p4<<<G, 256, 0, stream>>>(p);
  k_p5<<<G, 256, 0, stream>>>(p);
  k_p6<<<G, 256, 0, stream>>>(p);
  k_p7<<<G, 256, 0, stream>>>(p);
#endif
}
```

```cpp
#include <hip/hip_runtime.h>
#include <hip/hip_cooperative_groups.h>
#include <stdint.h>
#include <cmath>
#include <cstdio>
namespace cg = cooperative_groups;

#ifndef MEGA
#define MEGA 1
#endif

typedef unsigned short bf16_t;
using bf16x8 = __attribute__((ext_vector_type(8))) short;
using f32x16 = __attribute__((ext_vector_type(16))) float;
#define DI __device__ __forceinline__
#define MFMA(a, b, c) __builtin_amdgcn_mfma_f32_32x32x16_bf16((a), (b), (c), 0, 0, 0)

constexpr int T_TOK = 16384, SEQ = 8192;
constexpr float EPS = 1e-6f;
constexpr float LOG2E = 1.4426950408889634f;

constexpr size_t MiB = 1ull << 20;
constexpr int LD_WIN = 1088, LD_WUQ = 448, LD_WUKV = 320, LD_WMKV = 1088, LD_WOUT = 1600, LD_WGU = 1088, LD_WDN = 2880;
constexpr int LD_XB = 1088, LD_PH = 2112, LD_PM = 576, LD_YMLA = 576, LD_VT = 8256, LD_ACT = 2880;
constexpr size_t OFF_WT_IN = 0;
constexpr size_t OFF_WT_UQ = OFF_WT_IN + 3328ull * LD_WIN * 2;
constexpr size_t OFF_WT_UKV = OFF_WT_UQ + 768ull * LD_WUQ * 2;
constexpr size_t OFF_WT_MKV = OFF_WT_UKV + 1024ull * LD_WUKV * 2;
constexpr size_t OFF_WT_OUT = OFF_WT_MKV + 1024ull * LD_WMKV * 2;
constexpr size_t OFF_WT_GU = OFF_WT_OUT + 1024ull * LD_WOUT * 2;
constexpr size_t OFF_WT_DN = OFF_WT_GU + 5632ull * LD_WGU * 2;
constexpr size_t OFF_WT_END = OFF_WT_DN + 1024ull * LD_WDN * 2;
constexpr size_t OFF_SMALL = 31 * MiB;
static_assert(OFF_WT_END <= OFF_SMALL, "weights overflow");
constexpr size_t OFF_R0 = OFF_SMALL;
constexpr size_t OFF_RM = OFF_R0 + 65536;
constexpr size_t OFF_LB = OFF_RM + 2048;
constexpr size_t OFF_CNT = OFF_LB + 2048;
constexpr size_t OFF_SS = OFF_CNT + 256;
constexpr size_t OFF_COS = OFF_SS + 3 * 65536;
constexpr size_t OFF_SIN = OFF_COS + 2 * MiB;
constexpr size_t OFF_MEMB = OFF_SIN + 2 * MiB;
constexpr size_t OFF_MEMKV = OFF_MEMB + 1 * MiB;
constexpr size_t OFF_KMEM = OFF_MEMKV + 2 * MiB;
constexpr size_t OFF_VMEMT = OFF_KMEM + 512 * 1024;
constexpr size_t OFF_DEC = OFF_VMEMT + 512 * 1024;
constexpr size_t OFF_BAR = OFF_DEC + 512 * 1024;
constexpr size_t OFF_SSL = OFF_BAR + 16384;
constexpr size_t OFF_PROJA = 40 * MiB;
static_assert(OFF_SSL + 2 * 65536 <= OFF_PROJA, "small region overflow (ssl)");
static_assert(OFF_BAR + 16384 <= OFF_PROJA, "small region overflow");
constexpr size_t OFF_YMLA = OFF_PROJA;
constexpr size_t OFF_XB = 62 * MiB;
constexpr size_t OFF_L = OFF_XB;
constexpr size_t OFF_PROJH = 96 * MiB;
constexpr size_t OFF_PROJM = 162 * MiB;
constexpr size_t OFF_Q = 180 * MiB;
constexpr size_t OFF_K = 204 * MiB;
constexpr size_t OFF_VT = 228 * MiB;
constexpr size_t OFF_X1B = OFF_Q;
constexpr size_t OFF_ACT = 40 * MiB;
static_assert(OFF_VT + 1024ull * LD_VT * 2 <= 256 * MiB, "ws overflow");

struct Params {
  const float* x; const float* mem; const int* pos;
  const float *norm_mix, *norm_mem, *w_in, *q_a_norm, *w_uq, *kv_a_norm, *w_ukv, *mla_q_norm, *mla_k_norm, *lb_logits,
      *hg_out_norm, *w_mem_kv, *mem_q_norm, *mem_k_norm, *mla_out_norm, *mem_out_norm, *w_out, *norm_ffn, *w_gate, *w_up, *w_down;
  float* out; char* ws;
  double inv_freq[32];
};

DI float bf2f(bf16_t b) { return __uint_as_float(((unsigned)b) << 16); }
typedef __bf16 bf2_t __attribute__((ext_vector_type(2)));
typedef float f2_t __attribute__((ext_vector_type(2)));
DI unsigned pack2(float a, float b) { f2_t v = {a, b}; return __builtin_bit_cast(unsigned, __builtin_convertvector(v, bf2_t)); }
DI bf16_t f2bf(float x) { return (bf16_t)(pack2(x, 0.f) & 0xffffu); }
DI float lo2f(unsigned u) { return __uint_as_float(u << 16); }
DI float hi2f(unsigned u) { return __uint_as_float(u & 0xffff0000u); }
DI int crow(int reg, int h) { return (reg & 3) + 8 * (reg >> 2) + 4 * h; }
DI float wave_sum(float v) {
  for (int o = 32; o >= 1; o >>= 1) v += __shfl_xor(v, o, 64);
  return v;
}
DI float sigmoidf_(float x) { return __builtin_amdgcn_rcpf(1.f + __expf(-x)); }
DI bf16x8 pack8(const f32x16& x, int s) {
  uint4 p;
  p.x = pack2(x[8 * s + 0], x[8 * s + 1]); p.y = pack2(x[8 * s + 2], x[8 * s + 3]);
  p.z = pack2(x[8 * s + 4], x[8 * s + 5]); p.w = pack2(x[8 * s + 6], x[8 * s + 7]);
  return __builtin_bit_cast(bf16x8, p);
}
DI f32x16 zero16() { f32x16 z; for (int i = 0; i < 16; ++i) z[i] = 0.f; return z; }

constexpr int SMEM_BYTES = 74752;

DI float wgain(const Params& P, int gmode, const float* g1, int k) {
  if (gmode == 0) return 1.f;
  if (gmode == 1) return g1[k];
  return k < 512 ? P.mla_out_norm[k] : (k < 1024 ? 1.f : P.mem_out_norm[k - 1024]);
}
__device__ void transpose_cvt_tile(const Params& P, const float* W, int N, const float* g1, int gmode, bf16_t* Wt, int ldt,
                                   int rowmode, int kt, int nt, char* smem) {
  float(*tile)[65] = (float(*)[65])smem;
  const int tid = threadIdx.x, k0 = kt * 64, n0 = nt * 64;
  for (int i = 0; i < 16; ++i) {
    int idx = tid + 256 * i, kk = idx >> 6, nn = idx & 63;
    float v = 0.f;
    if (n0 + nn < N) v = W[(size_t)(k0 + kk) * N + n0 + nn] * wgain(P, gmode, g1, k0 + kk);
    tile[kk][nn] = v;
  }
  __syncthreads();
  for (int i = 0; i < 16; ++i) {
    int idx = tid + 256 * i, nn = idx >> 6, kk = idx & 63;
    int n = n0 + nn;
    int dr = rowmode == 0 ? n : ((n >> 5) * 64 + (n & 31) + (rowmode == 2 ? 32 : 0));
    Wt[(size_t)dr * ldt + k0 + kk] = f2bf(tile[kk][nn]);
  }
  __syncthreads();
}

__device__ void prep_transpose_job(const Params& P, int j, char* smem) {
  char* ws = P.ws;
  if (j < 832) { transpose_cvt_tile(P, P.w_in, 3264, P.norm_mix, 1, (bf16_t*)(ws + OFF_WT_IN), LD_WIN, 0, j / 52, j % 52, smem); return; }
  j -= 832;
  if (j < 72) { transpose_cvt_tile(P, P.w_uq, 768, P.q_a_norm, 1, (bf16_t*)(ws + OFF_WT_UQ), LD_WUQ, 0, j / 12, j % 12, smem); return; }
  j -= 72;
  if (j < 64) { transpose_cvt_tile(P, P.w_ukv, 1024, P.kv_a_norm, 1, (bf16_t*)(ws + OFF_WT_UKV), LD_WUKV, 0, j / 16, j % 16, smem); return; }
  j -= 64;
  if (j < 256) { transpose_cvt_tile(P, P.w_mem_kv, 1024, P.norm_mem, 1, (bf16_t*)(ws + OFF_WT_MKV), LD_WMKV, 0, j / 16, j % 16, smem); return; }
  j -= 256;
  if (j < 384) { transpose_cvt_tile(P, P.w_out, 1024, nullptr, 2, (bf16_t*)(ws + OFF_WT_OUT), LD_WOUT, 0, j / 16, j % 16, smem); return; }
  j -= 384;
  if (j < 704) { transpose_cvt_tile(P, P.w_gate, 2816, P.norm_ffn, 1, (bf16_t*)(ws + OFF_WT_GU), LD_WGU, 1, j / 44, j % 44, smem); return; }
  j -= 704;
  if (j < 704) { transpose_cvt_tile(P, P.w_up, 2816, P.norm_ffn, 1, (bf16_t*)(ws + OFF_WT_GU), LD_WGU, 2, j / 44, j % 44, smem); return; }
  j -= 704;
  transpose_cvt_tile(P, P.w_down, 1024, nullptr, 0, (bf16_t*)(ws + OFF_WT_DN), LD_WDN, 0, j / 16, j % 16, smem);
}

__device__ void phase0(const Params& P, int bid, int nb, char* smem) {
  char* ws = P.ws;
  const int tid = threadIdx.x, lane = tid & 63, wave = tid >> 6;
  constexpr int J_TR = 1224, J_ROWS = 4224, J_TAB = 2048, J_ZERO = 320, J_LB = 2;
  constexpr int J_TOTAL = J_TR + J_ROWS + J_TAB + J_ZERO + J_LB;
  for (int job = bid; job < J_TOTAL; job += nb) {
    if (job < J_TR) { prep_transpose_job(P, job, smem); continue; }
    int j = job - J_TR;
    if (j < J_ROWS) {
      int row = j * 4 + wave;
      const float* src; bf16_t* dst; float* rdst;
      if (row < T_TOK) { src = P.x + (size_t)row * 1024; dst = (bf16_t*)(ws + OFF_XB) + (size_t)row * LD_XB; rdst = (float*)(ws + OFF_R0) + row; }
      else { int r2 = row - T_TOK; src = P.mem + (size_t)r2 * 1024; dst = (bf16_t*)(ws + OFF_MEMB) + (size_t)r2 * 1024; rdst = (float*)(ws + OFF_RM) + r2; }
      float ss = 0.f;
      float4 v[4];
      for (int i = 0; i < 4; ++i) { v[i] = *(const float4*)(src + (i * 64 + lane) * 4); ss += v[i].x * v[i].x + v[i].y * v[i].y + v[i].z * v[i].z + v[i].w * v[i].w; }
      ss = wave_sum(ss);
      for (int i = 0; i < 4; ++i) { uint2 o; o.x = pack2(v[i].x, v[i].y); o.y = pack2(v[i].z, v[i].w); *(uint2*)(dst + (i * 64 + lane) * 4) = o; }
      if (lane == 0) *rdst = rsqrtf(ss * (1.f / 1024.f) + EPS);
      continue;
    }
    j -= J_ROWS;
    if (j < J_TAB) {
      int idx = j * 256 + tid;
      int t = idx >> 5, i = idx & 31;
      double ang = (double)P.pos[t] * P.inv_freq[i];
      double rev = ang * 0.15915494309189535;
      double fr = rev - rint(rev);
      float f = (float)fr;
      ((float*)(ws + OFF_COS))[idx] = __builtin_amdgcn_cosf(f);
      ((float*)(ws + OFF_SIN))[idx] = __builtin_amdgcn_sinf(f);
      continue;
    }
    j -= J_TAB;
    if (j < J_ZERO) { if (j < 192) ((float*)(ws + OFF_SS))[j * 256 + tid] = 0.f; else ((float*)(ws + OFF_SSL))[(j - 192) * 256 + tid] = 0.f; continue; }
    j -= J_ZERO;
    {
      int c = j * 256 + tid;
      float l0 = P.lb_logits[c], l1 = P.lb_logits[512 + c];
      ((float*)(ws + OFF_LB))[c] = 1.f / (1.f + __expf(l1 - l0));
      if (c < 4) ((unsigned*)(ws + OFF_CNT))[c] = 0u;
    }
  }
}

enum { EPI_PROJ = 0, EPI_MEMKV, EPI_Q, EPI_KV, EPI_OUT, EPI_GU, EPI_DOWN };
constexpr int G_ROWB = 144;
constexpr int G_ATILE = 256 * G_ROWB;
constexpr int G_STAGE = 384 * G_ROWB;
constexpr int LDS_RS = G_STAGE;
constexpr int CW_LD = 68;
constexpr int CW_BYTES = 32 * CW_LD * 4;

struct GArgs {
  const bf16_t *A0, *A1, *A2; int lda0, lda1, lda2; int kb0, kb1, kb2;
  int segIters, nIter, Ktot;
  const bf16_t* Bt; int ldb;
};

template <int EPI>
__device__ __forceinline__ void gemm_tile(const Params& P, const GArgs& g, int m0, int n0, char* smem) {
  const int tid = threadIdx.x, lane = tid & 63, wave = tid >> 6, r = lane & 31, h = lane >> 5;
  const int wm = wave >> 1, wn = wave & 1;
  char* ws = P.ws;
  float* rs = (float*)(smem + LDS_RS);
  float* f3 = rs + 256;

  if (EPI == EPI_Q || EPI == EPI_KV) {
    const float ssv = ((const float*)(ws + OFF_SSL))[(EPI == EPI_KV ? T_TOK : 0) + m0 + tid];
    rs[tid] = rsqrtf(ssv / (float)g.Ktot + EPS);
  }
  if (EPI == EPI_PROJ) rs[tid] = ((const float*)(ws + OFF_R0))[m0 + tid];
  if (EPI == EPI_MEMKV) rs[tid] = ((const float*)(ws + OFF_RM))[m0 + tid];
  if (EPI == EPI_GU) rs[tid] = rsqrtf(((const float*)(ws + OFF_SS))[2 * T_TOK + m0 + tid] * (1.f / 1024.f) + EPS);
  if (EPI == EPI_OUT) {
    const float* ssb = (const float*)(ws + OFF_SS);
    float r1 = rsqrtf(ssb[m0 + tid] * (1.f / 512.f) + EPS);
    float r3 = rsqrtf(ssb[T_TOK + m0 + tid] * (1.f / 512.f) + EPS);
    rs[tid] = r1 / r3; f3[tid] = r3;
  }

  f32x16 acc[4][2];
#pragma unroll
  for (int i = 0; i < 4; ++i) { acc[i][0] = zero16(); acc[i][1] = zero16(); }

  typedef unsigned u32x4_t __attribute__((ext_vector_type(4)));
  u32x4_t ra0, ra1, ra2, ra3, ra4, ra5, ra6, ra7, rb0, rb1, rb2, rb3;
  const bf16_t* const gA0 = g.A0; const bf16_t* const gA1 = g.A1; const bf16_t* const gA2 = g.A2;
  const int glda0 = g.lda0, glda1 = g.lda1, glda2 = g.lda2, gkb0 = g.kb0, gkb1 = g.kb1, gkb2 = g.kb2;
  const int segIters = g.segIters, nIter = g.nIter, ldb = g.ldb;
  const bf16_t* const gBt = g.Bt;
  const int lrow = tid >> 3, lkc = tid & 7;
#define GM_GLD(dst, voff, sbase) asm volatile("global_load_dwordx4 %0, %1, %2" : "=v"(dst) : "v"(voff), "s"(sbase) : "memory")
#define GM_LOADG(it_)                                                                   \
  {                                                                                     \
    const int seg_ = ((it_) >= segIters) + ((it_) >= 2 * segIters);                     \
    const int kk_ = ((it_) - seg_ * segIters) * 64;                                     \
    const bf16_t* Ap_ = gA0; int lda_ = glda0, kb_ = gkb0;                              \
    if (seg_ == 1) { Ap_ = gA1; lda_ = glda1; kb_ = gkb1; }                             \
    if (seg_ == 2) { Ap_ = gA2; lda_ = glda2; kb_ = gkb2; }                             \
    const bf16_t* ab_ = Ap_ + (size_t)m0 * lda_ + kk_;                                  \
    const bf16_t* bb_ = gBt + (size_t)n0 * ldb + kb_ + kk_;                             \
    const unsigned oa_ = (unsigned)(lrow * lda_ + lkc * 8) * 2u, sa2_ = (unsigned)lda_ * 64u; \
    const unsigned ob_ = (unsigned)(lrow * ldb + lkc * 8) * 2u, sb2_ = (unsigned)ldb * 64u;   \
    GM_GLD(ra0, oa_, ab_); GM_GLD(ra1, oa_ + sa2_, ab_); GM_GLD(ra2, oa_ + 2u * sa2_, ab_); GM_GLD(ra3, oa_ + 3u * sa2_, ab_); \
    GM_GLD(ra4, oa_ + 4u * sa2_, ab_); GM_GLD(ra5, oa_ + 5u * sa2_, ab_); GM_GLD(ra6, oa_ + 6u * sa2_, ab_); GM_GLD(ra7, oa_ + 7u * sa2_, ab_); \
    GM_GLD(rb0, ob_, bb_); GM_GLD(rb1, ob_ + sb2_, bb_); GM_GLD(rb2, ob_ + 2u * sb2_, bb_); GM_GLD(rb3, ob_ + 3u * sb2_, bb_); \
  }
#define GM_WAIT0()                                                                      \
  asm volatile("s_waitcnt vmcnt(0)"                                                     \
               : "+v"(ra0), "+v"(ra1), "+v"(ra2), "+v"(ra3), "+v"(ra4), "+v"(ra5), "+v"(ra6), "+v"(ra7),     \
                 "+v"(rb0), "+v"(rb1), "+v"(rb2), "+v"(rb3) : : "memory")
#define GM_STOREL()                                                                     \
  {                                                                                     \
    char* sa_ = smem + lrow * G_ROWB + lkc * 16;                                        \
    char* sb_ = sa_ + G_ATILE;                                                          \
    *(u32x4_t*)(sa_) = ra0; *(u32x4_t*)(sa_ + 32 * G_ROWB) = ra1;                       \
    *(u32x4_t*)(sa_ + 64 * G_ROWB) = ra2; *(u32x4_t*)(sa_ + 96 * G_ROWB) = ra3;         \
    *(u32x4_t*)(sa_ + 128 * G_ROWB) = ra4; *(u32x4_t*)(sa_ + 160 * G_ROWB) = ra5;       \
    *(u32x4_t*)(sa_ + 192 * G_ROWB) = ra6; *(u32x4_t*)(sa_ + 224 * G_ROWB) = ra7;       \
    *(u32x4_t*)(sb_) = rb0; *(u32x4_t*)(sb_ + 32 * G_ROWB) = rb1;                       \
    *(u32x4_t*)(sb_ + 64 * G_ROWB) = rb2; *(u32x4_t*)(sb_ + 96 * G_ROWB) = rb3;         \
  }
#define GM_COMPUTE()                                                                    \
  {                                                                                     \
    const char* sa_ = smem + (wm * 128 + r) * G_ROWB + h * 16;                          \
    const char* sb_ = smem + G_ATILE + (wn * 64 + r) * G_ROWB + h * 16;                 \
    _Pragma("unroll") for (int ks = 0; ks < 4; ++ks) {                                  \
      bf16x8 b0 = *(const bf16x8*)(sb_ + ks * 32);                                      \
      bf16x8 b1 = *(const bf16x8*)(sb_ + 32 * G_ROWB + ks * 32);                        \
      _Pragma("unroll") for (int i = 0; i < 4; ++i) {                                   \
        bf16x8 a = *(const bf16x8*)(sa_ + i * 32 * G_ROWB + ks * 32);                   \
        acc[i][0] = MFMA(a, b0, acc[i][0]);                                             \
        acc[i][1] = MFMA(a, b1, acc[i][1]);                                             \
      }                                                                                 \
    }                                                                                   \
  }

  GM_LOADG(0);
  GM_WAIT0();
  GM_STOREL();
  __syncthreads();
  if (nIter > 1) GM_LOADG(1);
#pragma unroll 1
  for (int it = 0; it < nIter; ++it) {
    if (EPI == EPI_OUT) {
      if (it == segIters || it == 2 * segIters) {
        const float* fac = (it == segIters) ? rs : f3;
#pragma unroll
        for (int i = 0; i < 4; ++i)
#pragma unroll
          for (int q = 0; q < 16; ++q) {
            float f = fac[wm * 128 + i * 32 + crow(q, h)];
            acc[i][0][q] *= f; acc[i][1][q] *= f;
          }
      }
    }
    __builtin_amdgcn_s_setprio(1);
    GM_COMPUTE();
    __builtin_amdgcn_s_setprio(0);
    __syncthreads();
    if (it + 1 < nIter) {
      GM_WAIT0();
      GM_STOREL();
    }
    __syncthreads();
    if (it + 2 < nIter) GM_LOADG(it + 2);
  }

  float* Cw = (float*)(smem + wave * CW_BYTES);
  const int ncol0 = n0 + wn * 64;
#pragma unroll
  for (int i = 0; i < 4; ++i) {
    const int mrow0 = wm * 128 + i * 32;
#pragma unroll
    for (int j = 0; j < 2; ++j)
#pragma unroll
      for (int q = 0; q < 16; ++q) Cw[crow(q, h) * CW_LD + j * 32 + r] = acc[i][j][q];
    __builtin_amdgcn_fence(__ATOMIC_RELEASE, "wavefront");
    if (EPI == EPI_KV && ((ncol0 >> 7) & 1)) {
      const int hh = ncol0 >> 8, c = (ncol0 & 127) + lane;
      const int b = m0 >> 13, s0 = (m0 & (SEQ - 1)) + mrow0;
      bf16_t* vt = (bf16_t*)(ws + OFF_VT) + (((size_t)((b * 4 + hh) * 128 + (s0 >> 6))) * 128 + c) * 64 + (s0 & 63);
#pragma unroll
      for (int g8 = 0; g8 < 4; ++g8) {
        float v[8];
#pragma unroll
        for (int k = 0; k < 8; ++k) v[k] = Cw[(g8 * 8 + k) * CW_LD + lane] * rs[mrow0 + g8 * 8 + k];
        uint4 o; o.x = pack2(v[0], v[1]); o.y = pack2(v[2], v[3]); o.z = pack2(v[4], v[5]); o.w = pack2(v[6], v[7]);
        *(uint4*)(vt + g8 * 8) = o;
      }
    } else if (EPI == EPI_GU) {
      const int L8 = lane & 7, rs8 = lane >> 3;
#pragma unroll 2
      for (int p = 0; p < 4; ++p) {
        const int row = p * 8 + rs8, m = m0 + mrow0 + row;
        float4 v0 = *(const float4*)(Cw + row * CW_LD + 4 * L8);
        float4 v1 = *(const float4*)(Cw + row * CW_LD + 32 + 4 * L8);
        float s = rs[mrow0 + row];
        float gx[4] = {v0.x * s, v0.y * s, v0.z * s, v0.w * s};
        float ux[4] = {v1.x * s, v1.y * s, v1.z * s, v1.w * s};
        float a[4];
#pragma unroll
        for (int q = 0; q < 4; ++q) a[q] = gx[q] * sigmoidf_(gx[q]) * ux[q];
        uint2 u; u.x = pack2(a[0], a[1]); u.y = pack2(a[2], a[3]);
        *(uint2*)((bf16_t*)(ws + OFF_ACT) + (size_t)m * LD_ACT + (ncol0 >> 1) + 4 * L8) = u;
      }
    } else {
      const int L = lane & 15, rsub = lane >> 4;
      constexpr int UNR_ = (EPI == EPI_OUT || EPI == EPI_DOWN) ? 4 : 2;
#pragma clang loop unroll_count(UNR_)
      for (int p = 0; p < 8; ++p) {
        const int row = p * 4 + rsub, trow = mrow0 + row, m = m0 + trow;
        const int n = ncol0 + 4 * L;
        float4 v = *(const float4*)(Cw + row * CW_LD + 4 * L);
        if (EPI == EPI_PROJ) {
          float s = rs[trow];
          uint2 o; o.x = pack2(v.x * s, v.y * s); o.y = pack2(v.z * s, v.w * s);
          if (n < 704) *(uint2*)((bf16_t*)(ws + OFF_PROJA) + (size_t)m * 704 + n) = o;
          else if (n < 2752) *(uint2*)((bf16_t*)(ws + OFF_PROJH) + (size_t)m * LD_PH + (n - 704)) = o;
          else if (n < 3264) *(uint2*)((bf16_t*)(ws + OFF_PROJM) + (size_t)m * LD_PM + (n - 2752)) = o;
          if (ncol0 < 640) {
            float q0_ = lo2f(o.x), q1_ = hi2f(o.x), q2_ = lo2f(o.y), q3_ = hi2f(o.y);
            float ssq = q0_ * q0_ + q1_ * q1_ + q2_ * q2_ + q3_ * q3_;
            ssq += __shfl_xor(ssq, 1, 64); ssq += __shfl_xor(ssq, 2, 64); ssq += __shfl_xor(ssq, 4, 64); ssq += __shfl_xor(ssq, 8, 64);
            if (L == 0) atomicAdd((float*)(ws + OFF_SSL) + (ncol0 < 384 ? 0 : T_TOK) + m, ssq);
          }
        } else if (EPI == EPI_MEMKV) {
          float s = rs[trow];
          *(float4*)((float*)(ws + OFF_MEMKV) + (size_t)m * 1024 + n) = make_float4(v.x * s, v.y * s, v.z * s, v.w * s);
        } else if (EPI == EPI_Q) {
          float s = rs[trow];
          uint2 u; u.x = pack2(v.x * s, v.y * s); u.y = pack2(v.z * s, v.w * s);
          *(uint2*)((bf16_t*)(ws + OFF_Q) + (size_t)m * 768 + n) = u;
        } else if (EPI == EPI_KV) {
          float s = rs[trow];
          uint2 u; u.x = pack2(v.x * s, v.y * s); u.y = pack2(v.z * s, v.w * s);
          *(uint2*)((bf16_t*)(ws + OFF_K) + ((size_t)((m >> 13) * 4 + (n >> 8)) * SEQ + (m & (SEQ - 1))) * 192 + (n & 127)) = u;
        } else if (EPI == EPI_OUT) {
          float4 xin = *(const float4*)(P.x + (size_t)m * 1024 + n);
          float4 o = make_float4(xin.x + v.x, xin.y + v.y, xin.z + v.z, xin.w + v.w);
          *(float4*)(P.out + (size_t)m * 1024 + n) = o;
          uint2 u; u.x = pack2(o.x, o.y); u.y = pack2(o.z, o.w);
          *(uint2*)((bf16_t*)(ws + OFF_X1B) + (size_t)m * LD_XB + n) = u;
          float ssq = o.x * o.x + o.y * o.y + o.z * o.z + o.w * o.w;
          ssq += __shfl_xor(ssq, 1, 64); ssq += __shfl_xor(ssq, 2, 64); ssq += __shfl_xor(ssq, 4, 64); ssq += __shfl_xor(ssq, 8, 64);
          if (L == 0) atomicAdd((float*)(ws + OFF_SS) + 2 * T_TOK + m, ssq);
        } else if (EPI == EPI_DOWN) {
          float4 xin = *(const float4*)(P.out + (size_t)m * 1024 + n);
          *(float4*)(P.out + (size_t)m * 1024 + n) = make_float4(xin.x + v.x, xin.y + v.y, xin.z + v.z, xin.w + v.w);
        }
      }
    }
    __builtin_amdgcn_fence(__ATOMIC_ACQUIRE, "wavefront");
  }
  __syncthreads();
}

DI GArgs garg1(const bf16_t* A, int lda, int K, const bf16_t* Bt, int ldb) {
  GArgs g;
  g.A0 = g.A1 = g.A2 = A; g.lda0 = g.lda1 = g.lda2 = lda; g.kb0 = g.kb1 = g.kb2 = 0;
  g.segIters = K / 64; g.nIter = K / 64; g.Ktot = K; g.Bt = Bt; g.ldb = ldb;
  return g;
}

DI void tile_mn(int t, int NT, int& mt, int& nt) {
  int grp = t / (32 * NT), rem = t - grp * 32 * NT;
  nt = rem >> 5; mt = grp * 32 + (rem & 31);
}

__device__ void phase1(const Params& P, int bid, int nb, char* smem) {
  char* ws = P.ws;
  GArgs g1 = garg1((const bf16_t*)(ws + OFF_XB), LD_XB, 1024, (const bf16_t*)(ws + OFF_WT_IN), LD_WIN);
  GArgs g2 = garg1((const bf16_t*)(ws + OFF_MEMB), 1024, 1024, (const bf16_t*)(ws + OFF_WT_MKV), LD_WMKV);
  constexpr int NT1 = 64 * 26;
  for (int t = bid; t < NT1 + 16; t += nb) {
    if (t < NT1) { int mt, nt; tile_mn(t, 26, mt, nt); gemm_tile<EPI_PROJ>(P, g1, mt * 256, nt * 128, smem); }
    else { int u = t - NT1; gemm_tile<EPI_MEMKV>(P, g2, (u & 1) * 256, (u >> 1) * 128, smem); }
  }
  {
    const int rem = (NT1 + 16) % nb;
    const int first = rem == 0 ? 0 : rem, stride = nb - first;
    if (bid >= first)
      for (int u = bid - first; u < 2496; u += stride) prep_transpose_job(P, 1224 + u, smem);
  }
}

constexpr int VT_ROWB = 144;
constexpr int QK_ROWB = 272;
DI void hg_tile_to_lds(const bf16_t* src, char* dst) {
  const int tid = threadIdx.x;
  uint4 v0, v1, v2, v3;
  {
    const int t = tid >> 4, dc = tid & 15;
    const bf16_t* p = src + (size_t)t * LD_PH + dc * 8;
    v0 = *(const uint4*)(p); v1 = *(const uint4*)(p + (size_t)16 * LD_PH);
    v2 = *(const uint4*)(p + (size_t)32 * LD_PH); v3 = *(const uint4*)(p + (size_t)48 * LD_PH);
    char* d = dst + t * QK_ROWB + dc * 16;
    *(uint4*)(d) = v0; *(uint4*)(d + 16 * QK_ROWB) = v1; *(uint4*)(d + 32 * QK_ROWB) = v2; *(uint4*)(d + 48 * QK_ROWB) = v3;
  }
}
DI void hg_build_vT(const bf16_t* src, char* svT) {
  const int tid = threadIdx.x;
  const int t = tid & 63, dc0 = tid >> 6;
  uint4 v0, v1, v2, v3;
  const bf16_t* p = src + (size_t)t * LD_PH + dc0 * 8;
  v0 = *(const uint4*)(p); v1 = *(const uint4*)(p + 32); v2 = *(const uint4*)(p + 64); v3 = *(const uint4*)(p + 96);
#define HG_SCATTER(v, i)                                                        \
  {                                                                             \
    char* d = svT + ((dc0 + 4 * (i)) * 8) * VT_ROWB + t * 2;                    \
    *(bf16_t*)(d) = (bf16_t)(v.x & 0xffff); *(bf16_t*)(d + VT_ROWB) = (bf16_t)(v.x >> 16);             \
    *(bf16_t*)(d + 2 * VT_ROWB) = (bf16_t)(v.y & 0xffff); *(bf16_t*)(d + 3 * VT_ROWB) = (bf16_t)(v.y >> 16); \
    *(bf16_t*)(d + 4 * VT_ROWB) = (bf16_t)(v.z & 0xffff); *(bf16_t*)(d + 5 * VT_ROWB) = (bf16_t)(v.z >> 16); \
    *(bf16_t*)(d + 6 * VT_ROWB) = (bf16_t)(v.w & 0xffff); *(bf16_t*)(d + 7 * VT_ROWB) = (bf16_t)(v.w >> 16); \
  }
  HG_SCATTER(v0, 0) HG_SCATTER(v1, 1) HG_SCATTER(v2, 2) HG_SCATTER(v3, 3)
}

__device__ void hg_local_state(const Params& P, int item, char* smem) {
  char* ws = P.ws;
  const int tid = threadIdx.x, lane = tid & 63, wave = tid >> 6, r = lane & 31, h = lane >> 5;
  const int bh = item >> 7, c = item & 127, b = bh >> 2, hh = bh & 3;
  const int t0 = b * SEQ + c * 64;
  char* svT = smem;
  char* skT = smem + 128 * VT_ROWB;
  char* sraw = smem + 256 * VT_ROWB;
  const bf16_t* src = (const bf16_t*)(ws + OFF_PROJH) + (size_t)t0 * LD_PH + hh * 128;
  hg_tile_to_lds(src + 512, sraw);
  hg_build_vT(src + 1024, svT);
  __syncthreads();
  if (tid < 128) {
    const int d = tid;
    const float lb = ((const float*)(ws + OFF_LB))[hh * 128 + d];
    float run = 0.f;
    for (int j = 7; j >= 0; --j) {
      float v[8];
#pragma unroll
      for (int i = 7; i >= 0; --i) {
        float f = lb + (1.f - lb) * sigmoidf_(bf2f(*(const bf16_t*)(sraw + (8 * j + i) * QK_ROWB + d * 2)));
        v[i] = (1.f - f) * __builtin_amdgcn_exp2f(run);
        run += __builtin_amdgcn_logf(f);
      }
      uint4 o; o.x = pack2(v[0], v[1]); o.y = pack2(v[2], v[3]); o.z = pack2(v[4], v[5]); o.w = pack2(v[6], v[7]);
      *(uint4*)(skT + d * VT_ROWB + j * 16) = o;
    }
    ((float*)(ws + OFF_DEC))[(size_t)(bh * 128 + c) * 128 + d] = __builtin_amdgcn_exp2f(run);
  }
  __syncthreads();
  f32x16 acc[4];
  for (int i = 0; i < 4; ++i) acc[i] = zero16();
#pragma unroll
  for (int ks = 0; ks < 4; ++ks) {
    bf16x8 a = *(const bf16x8*)(svT + (wave * 32 + r) * VT_ROWB + ks * 32 + h * 16);
#pragma unroll
    for (int dt = 0; dt < 4; ++dt) {
      bf16x8 bb = *(const bf16x8*)(skT + (dt * 32 + r) * VT_ROWB + ks * 32 + h * 16);
      acc[dt] = MFMA(a, bb, acc[dt]);
    }
  }
  bf16_t* L = (bf16_t*)(ws + OFF_L) + (size_t)(bh * 128 + c) * 16384;
#pragma unroll
  for (int dt = 0; dt < 4; ++dt)
#pragma unroll
    for (int q = 0; q < 16; ++q) L[(wave * 32 + crow(q, h)) * 128 + dt * 32 + r] = f2bf(acc[dt][q]);
  __syncthreads();
}

__device__ void phase2(const Params& P, int bid, int nb, char* smem) {
  char* ws = P.ws;
  GArgs gq = garg1((const bf16_t*)(ws + OFF_PROJA), 704, 384, (const bf16_t*)(ws + OFF_WT_UQ), LD_WUQ);
  GArgs gkv = garg1((const bf16_t*)(ws + OFF_PROJA) + 384, 704, 256, (const bf16_t*)(ws + OFF_WT_UKV), LD_WUKV);
  constexpr int NQ = 64 * 6, NKV = 64 * 8, NH = 1024;
  for (int t = bid; t < NQ + NKV + NH; t += nb) {
    if (t < NQ) { int mt, nt; tile_mn(t, 6, mt, nt); gemm_tile<EPI_Q>(P, gq, mt * 256, nt * 128, smem); }
    else if (t < NQ + NKV) { int mt, nt; tile_mn(t - NQ, 8, mt, nt); gemm_tile<EPI_KV>(P, gkv, mt * 256, nt * 128, smem); }
    else hg_local_state(P, t - NQ - NKV, smem);
  }
}

__device__ void phase3(const Params& P, int bid, int nb, char* smem) {
  char* ws = P.ws;
  const int tid = threadIdx.x, lane = tid & 63, wave = tid >> 6;
  constexpr int J_SCAN = 512, J_NORM = 4096, J_MEMK = 128;
  for (int job = bid; job < J_SCAN + J_NORM + J_MEMK; job += nb) {
    if (job < J_SCAN) {
      int idx = job * 256 + tid;
      int d = idx & 127, e = (idx >> 7) & 127, bh = idx >> 14;
      bf16_t* L = (bf16_t*)(ws + OFF_L) + (size_t)bh * 128 * 16384 + e * 128 + d;
      const float* dec = (const float*)(ws + OFF_DEC) + (size_t)bh * 128 * 128 + d;
      float S = 0.f;
      float tA[16], dA[16], tB[16], dB[16];
#pragma unroll
      for (int i = 0; i < 16; ++i) { tA[i] = bf2f(L[(size_t)i * 16384]); dA[i] = dec[i * 128]; }
#pragma unroll 1
      for (int c0 = 0; c0 < 128; c0 += 32) {
#pragma unroll
        for (int i = 0; i < 16; ++i) { tB[i] = bf2f(L[(size_t)(c0 + 16 + i) * 16384]); dB[i] = dec[(c0 + 16 + i) * 128]; }
#pragma unroll
        for (int i = 0; i < 16; ++i) { L[(size_t)(c0 + i) * 16384] = f2bf(S); S = dA[i] * S + tA[i]; }
        if (c0 + 32 < 128) {
#pragma unroll
          for (int i = 0; i < 16; ++i) { tA[i] = bf2f(L[(size_t)(c0 + 32 + i) * 16384]); dA[i] = dec[(c0 + 32 + i) * 128]; }
        }
#pragma unroll
        for (int i = 0; i < 16; ++i) { L[(size_t)(c0 + 16 + i) * 16384] = f2bf(S); S = dB[i] * S + tB[i]; }
      }
      continue;
    }
    int j = job - J_SCAN;
    if (j < J_NORM) {
      const int t = j * 4 + wave;
      const float cs = ((const float*)(ws + OFF_COS))[t * 32 + (lane & 31)];
      const float sn = ((const float*)(ws + OFF_SIN))[t * 32 + (lane & 31)];
      const float sgn = lane < 32 ? -1.f : 1.f;
      const float qscale = 0.07216878364870322f * LOG2E;
      bf16_t* Q = (bf16_t*)(ws + OFF_Q) + (size_t)t * 768;
      bf16_t* K = (bf16_t*)(ws + OFF_K) + ((size_t)((t >> 13) * 4) * SEQ + (t & (SEQ - 1))) * 192;
      const float kr = bf2f(((const bf16_t*)(ws + OFF_PROJA))[(size_t)t * 704 + 640 + lane]);
      const float gq0 = P.mla_q_norm[lane], gq1 = P.mla_q_norm[64 + lane], gq2 = P.mla_q_norm[128 + lane];
      const float gk0 = P.mla_k_norm[lane], gk1 = P.mla_k_norm[64 + lane], gk2 = P.mla_k_norm[128 + lane];
      bf16_t* M = (bf16_t*)(ws + OFF_PROJM) + (size_t)t * LD_PM;
      const float gm0 = P.mem_q_norm[lane], gm1 = P.mem_q_norm[64 + lane];
      float qv[4][3], kv[4][2], mv[4][2];
#pragma unroll
      for (int hh = 0; hh < 4; ++hh) {
        qv[hh][0] = bf2f(Q[hh * 192 + lane]); qv[hh][1] = bf2f(Q[hh * 192 + 64 + lane]); qv[hh][2] = bf2f(Q[hh * 192 + 128 + lane]);
        kv[hh][0] = bf2f(K[(size_t)hh * SEQ * 192 + lane]); kv[hh][1] = bf2f(K[(size_t)hh * SEQ * 192 + 64 + lane]);
        mv[hh][0] = bf2f(M[hh * 128 + lane]); mv[hh][1] = bf2f(M[hh * 128 + 64 + lane]);
      }
      float sq[4], sk[4], sm[4];
#pragma unroll
      for (int hh = 0; hh < 4; ++hh) {
        sq[hh] = qv[hh][0] * qv[hh][0] + qv[hh][1] * qv[hh][1] + qv[hh][2] * qv[hh][2];
        sk[hh] = kv[hh][0] * kv[hh][0] + kv[hh][1] * kv[hh][1] + kr * kr;
        sm[hh] = mv[hh][0] * mv[hh][0] + mv[hh][1] * mv[hh][1];
      }
#pragma unroll
      for (int o = 32; o >= 1; o >>= 1) {
#pragma unroll
        for (int hh = 0; hh < 4; ++hh) {
          sq[hh] += __shfl_xor(sq[hh], o, 64); sk[hh] += __shfl_xor(sk[hh], o, 64); sm[hh] += __shfl_xor(sm[hh], o, 64);
        }
      }
#pragma unroll
      for (int hh = 0; hh < 4; ++hh) {
        {
          float rstd = rsqrtf(sq[hh] * (1.f / 192.f) + EPS);
          float n0 = qv[hh][0] * rstd * gq0, n1 = qv[hh][1] * rstd * gq1, n2 = qv[hh][2] * rstd * gq2;
          float pr = __shfl_xor(n2, 32, 64);
          float ro = n2 * cs + sgn * pr * sn;
          Q[hh * 192 + lane] = f2bf(n0 * qscale); Q[hh * 192 + 64 + lane] = f2bf(n1 * qscale); Q[hh * 192 + 128 + lane] = f2bf(ro * qscale);
        }
        {
          float rstd = rsqrtf(sk[hh] * (1.f / 192.f) + EPS);
          float n0 = kv[hh][0] * rstd * gk0, n1 = kv[hh][1] * rstd * gk1, n2 = kr * rstd * gk2;
          float pr = __shfl_xor(n2, 32, 64);
          float ro = n2 * cs + sgn * pr * sn;
          K[(size_t)hh * SEQ * 192 + lane] = f2bf(n0); K[(size_t)hh * SEQ * 192 + 64 + lane] = f2bf(n1); K[(size_t)hh * SEQ * 192 + 128 + lane] = f2bf(ro);
        }
        {
          float rstd = rsqrtf(sm[hh] * (1.f / 128.f) + EPS) * (0.08838834764831845f * LOG2E);
          M[hh * 128 + lane] = f2bf(mv[hh][0] * rstd * gm0); M[hh * 128 + 64 + lane] = f2bf(mv[hh][1] * rstd * gm1);
        }
      }
      continue;
    }
    j -= J_NORM;
    {
      const int m = j * 4 + wave;
      const int b = m >> 8, key = m & 255;
      const float* src = (const float*)(ws + OFF_MEMKV) + (size_t)m * 1024;
      for (int hh = 0; hh < 4; ++hh) {
        float v0 = src[hh * 128 + lane], v1 = src[hh * 128 + 64 + lane];
        float ss = wave_sum(v0 * v0 + v1 * v1);
        float rstd = rsqrtf(ss * (1.f / 128.f) + EPS);
        bf16_t* km = (bf16_t*)(ws + OFF_KMEM) + ((size_t)((b * 4 + hh) * 256 + key)) * 128;
        km[lane] = f2bf(v0 * rstd * P.mem_k_norm[lane]); km[64 + lane] = f2bf(v1 * rstd * P.mem_k_norm[64 + lane]);
        bf16_t* vm = (bf16_t*)(ws + OFF_VMEMT) + ((size_t)(b * 4 + hh) * 128) * 256 + key;
        vm[(size_t)lane * 256] = f2bf(src[512 + hh * 128 + lane]);
        vm[(size_t)(64 + lane) * 256] = f2bf(src[512 + hh * 128 + 64 + lane]);
      }
    }
  }
}

constexpr int AV_ROWB = 136;
template <int DQK, bool CAUSAL>
__device__ __forceinline__ void attn_item(const bf16_t* Q, int ldq, const bf16_t* K, int ldk, const bf16_t* Vt, int ldv, int vts, int q0, int nkeys,
                          bf16_t* Y, int ldy, float* ssout, char* smem) {
  constexpr int KROWB = (DQK + 8) * 2;
  constexpr int KCH = DQK / 8;
  constexpr int NKL = (64 * KCH) / 256;
  constexpr int NKS = DQK / 16;
  int tid = threadIdx.x;
  asm volatile("" : "+v"(tid));
  const int lane = tid & 63, wave = tid >> 6, r = lane & 31, h = lane >> 5;
  const int rg = wave & 1, kh = wave >> 1;
  char* sK = smem;
  char* sV = smem + 64 * KROWB;
  const int qrow = q0 + rg * 32 + r;

  char* sQ = smem + 64 * KROWB + 128 * AV_ROWB;
  f32x16 oacc[4];
  for (int i = 0; i < 4; ++i) oacc[i] = zero16();
  float m_run = -INFINITY, l_run = 0.f;
  const int ntiles = CAUSAL ? (q0 + 64) / 64 : nkeys / 64;

  uint4 rk0, rk1, rk2, rk3, rk4, rk5, rv0, rv1, rv2, rv3;
  rk4 = make_uint4(0, 0, 0, 0); rk5 = rk4;
#define AT_KOFF(i) ((unsigned)(((tid + 256 * (i)) / KCH) * ldk + ((tid + 256 * (i)) % KCH) * 8) * 2u)
#define AT_VOFF(i) ((unsigned)(((tid + 256 * (i)) >> 3) * ldv + ((tid + 256 * (i)) & 7) * 8) * 2u)
#define AT_KLDS(i) (sK + ((tid + 256 * (i)) / KCH) * KROWB + ((tid + 256 * (i)) % KCH) * 16)
#define AT_VLDS(i) (sV + ((tid + 256 * (i)) >> 3) * AV_ROWB + ((tid + 256 * (i)) & 7) * 16)
#define AT_LOADG(kt_)                                                                   \
  {                                                                                     \
    const char* kb_ = (const char*)(K + (size_t)(kt_) * 64 * ldk);                      \
    const char* vb_ = (const char*)(Vt + (size_t)(kt_) * vts);                          \
    rk0 = *(const uint4*)(kb_ + AT_KOFF(0)); rk1 = *(const uint4*)(kb_ + AT_KOFF(1));   \
    rk2 = *(const uint4*)(kb_ + AT_KOFF(2)); rk3 = *(const uint4*)(kb_ + AT_KOFF(3));   \
    if (NKL > 4) { rk4 = *(const uint4*)(kb_ + AT_KOFF(4)); rk5 = *(const uint4*)(kb_ + AT_KOFF(5)); } \
    rv0 = *(const uint4*)(vb_ + AT_VOFF(0)); rv1 = *(const uint4*)(vb_ + AT_VOFF(1));   \
    rv2 = *(const uint4*)(vb_ + AT_VOFF(2)); rv3 = *(const uint4*)(vb_ + AT_VOFF(3));   \
  }
#define AT_VST(i, v)                                                    \
  {                                                                     \
    *(uint2*)(AT_VLDS(i)) = make_uint2(v.x, v.y);                       \
    *(uint2*)(AT_VLDS(i) + 8) = make_uint2(v.z, v.w);                   \
  }
#define AT_STOREL()                                                                     \
  {                                                                                     \
    *(uint4*)(AT_KLDS(0)) = rk0; *(uint4*)(AT_KLDS(1)) = rk1;                           \
    *(uint4*)(AT_KLDS(2)) = rk2; *(uint4*)(AT_KLDS(3)) = rk3;                           \
    if (NKL > 4) { *(uint4*)(AT_KLDS(4)) = rk4; *(uint4*)(AT_KLDS(5)) = rk5; }          \
    AT_VST(0, rv0) AT_VST(1, rv1) AT_VST(2, rv2) AT_VST(3, rv3)                         \
  }

  AT_LOADG(0);
  for (int c = tid; c < 64 * KCH; c += 256) {
    const int row = c / KCH, kc = c - row * KCH;
    *(uint4*)(sQ + row * KROWB + kc * 16) = *(const uint4*)(Q + (size_t)(q0 + row) * ldq + kc * 8);
  }

  AT_STOREL();
  __syncthreads();
  constexpr int NQR = (NKS * 3) / 4;
  bf16x8 qh[NQR];
#pragma unroll
  for (int ks = 0; ks < NQR; ++ks) qh[ks] = *(const bf16x8*)(sQ + (rg * 32 + r) * KROWB + ks * 32 + h * 16);
  for (int kt = 0; kt < ntiles; ++kt) {
    if (kt + 1 < ntiles) AT_LOADG(kt + 1);
    __builtin_amdgcn_sched_barrier(0);
    const int k0 = kt * 64 + kh * 32;
    f32x16 sc = zero16();
    __builtin_amdgcn_s_setprio(1);
#pragma unroll
    for (int ks = 0; ks < NKS; ++ks) {
      bf16x8 a0 = *(const bf16x8*)(sK + (kh * 32 + r) * KROWB + ks * 32 + h * 16);
      bf16x8 bq;
      if (ks < NQR) bq = qh[ks < NQR ? ks : 0]; else bq = *(const bf16x8*)(sQ + (rg * 32 + r) * KROWB + ks * 32 + h * 16);
      sc = MFMA(a0, bq, sc);

    }
    if (CAUSAL) {
      if (k0 + 31 > q0 + rg * 32) {
#pragma unroll
        for (int q = 0; q < 16; ++q) {
          int key = k0 + crow(q, h);
          if (key > qrow) sc[q] = -INFINITY;
        }
      }
    }
    float mx = sc[0];
#pragma unroll
    for (int q = 1; q < 16; ++q) mx = fmaxf(mx, sc[q]);
    {
      auto sw = __builtin_amdgcn_permlane32_swap(__float_as_uint(mx), __float_as_uint(mx), false, false);
      mx = fmaxf(__uint_as_float(sw[0]), __uint_as_float(sw[1]));
    }
    if (__builtin_amdgcn_ballot_w64(mx > m_run + 8.f) != 0ull) {
      const float m_new = fmaxf(m_run, mx);
      const float m_safe = (m_new == -INFINITY) ? 0.f : m_new;
      const float alpha = __builtin_amdgcn_exp2f(m_run - m_safe);
      m_run = m_new;
      l_run *= alpha;
#pragma unroll
      for (int dt = 0; dt < 4; ++dt)
#pragma unroll
        for (int q = 0; q < 16; ++q) oacc[dt][q] *= alpha;
    }
    const float m_ref = (m_run == -INFINITY) ? 0.f : m_run;
    float ls = 0.f;
#pragma unroll
    for (int q = 0; q < 16; ++q) { sc[q] = __builtin_amdgcn_exp2f(sc[q] - m_ref); ls += sc[q]; }
    l_run += ls;
#pragma unroll
    for (int s2 = 0; s2 < 2; ++s2) {
      bf16x8 pb = pack8(sc, s2);
#pragma unroll
      for (int dt = 0; dt < 4; ++dt) {
        const char* vp = sV + (dt * 32 + r) * AV_ROWB + (32 * kh + 16 * s2 + 4 * h) * 2;
        uint2 lo = *(const uint2*)vp;
        uint2 hi = *(const uint2*)(vp + 16);
        uint4 av = make_uint4(lo.x, lo.y, hi.x, hi.y);
        oacc[dt] = MFMA(__builtin_bit_cast(bf16x8, av), pb, oacc[dt]);
      }
      __builtin_amdgcn_sched_barrier(0);
    }
    __builtin_amdgcn_s_setprio(0);
    __syncthreads();
    if (kt + 1 < ntiles) { AT_STOREL(); }
    __syncthreads();
  }
  float* mO = (float*)smem + rg * (66 * 64);
  if (kh == 1) {
#pragma unroll
    for (int dt = 0; dt < 4; ++dt)
#pragma unroll
      for (int q = 0; q < 16; ++q) mO[(dt * 16 + q) * 64 + lane] = oacc[dt][q];
    mO[64 * 64 + lane] = m_run;
    mO[65 * 64 + lane] = l_run;
  }
  __syncthreads();
  if (kh == 0) {
    const float m_b = mO[64 * 64 + lane], l_b = mO[65 * 64 + lane];
    const float m = fmaxf(m_run, m_b);
    const float fa = __builtin_amdgcn_exp2f(m_run - m), fb = __builtin_amdgcn_exp2f(m_b - m);
    float lsum = l_run * fa + l_b * fb;
    lsum += __shfl_xor(lsum, 32, 64);
    const float inv = 1.f / lsum;
    const float ca = fa * inv, cb = fb * inv;
    float ssq = 0.f;
#pragma unroll
    for (int dt = 0; dt < 4; ++dt)
#pragma unroll
      for (int g4 = 0; g4 < 4; ++g4) {
        float o0 = oacc[dt][4 * g4] * ca + mO[(dt * 16 + 4 * g4) * 64 + lane] * cb;
        float o1 = oacc[dt][4 * g4 + 1] * ca + mO[(dt * 16 + 4 * g4 + 1) * 64 + lane] * cb;
        float o2 = oacc[dt][4 * g4 + 2] * ca + mO[(dt * 16 + 4 * g4 + 2) * 64 + lane] * cb;
        float o3 = oacc[dt][4 * g4 + 3] * ca + mO[(dt * 16 + 4 * g4 + 3) * 64 + lane] * cb;
        ssq += o0 * o0 + o1 * o1 + o2 * o2 + o3 * o3;
        uint2 u; u.x = pack2(o0, o1); u.y = pack2(o2, o3);
        *(uint2*)(Y + (size_t)qrow * ldy + dt * 32 + 8 * g4 + 4 * h) = u;
      }
    ssq += __shfl_xor(ssq, 32, 64);
    if (h == 0) atomicAdd(ssout + qrow, ssq);
  }
  __syncthreads();
}

template <int DQK, bool CAUSAL>
__device__ __forceinline__ void attn_item128(const bf16_t* Q, int ldq, const bf16_t* K, int ldk, const bf16_t* Vt, int ldv, int vts,
                                          int q0, int kt0, int kt1, bf16_t* Y, int ldy, float* ssout, char* smem) {
  constexpr int KROWB = (DQK + 8) * 2;
  constexpr int KCH = DQK / 8;
  constexpr int NKL = (64 * KCH) / 256;
  constexpr int NKS = DQK / 16;
  int tid = threadIdx.x;
  asm volatile("" : "+v"(tid));
  const int lane = tid & 63, wave = tid >> 6, r = lane & 31, h = lane >> 5;
  char* sK = smem;
  char* sV = smem + 64 * KROWB;
  const int qrow = q0 + wave * 32 + r;

  bf16x8 qf[NKS];
#pragma unroll
  for (int ks = 0; ks < NKS; ++ks) qf[ks] = *(const bf16x8*)(Q + (size_t)qrow * ldq + ks * 16 + h * 8);

  f32x16 oacc[4];
  for (int i = 0; i < 4; ++i) oacc[i] = zero16();
  float m_run = -INFINITY, l_run = 0.f;

  uint4 rk0, rk1, rk2, rk3, rk4, rk5, rv0, rv1, rv2, rv3;
  rk4 = make_uint4(0, 0, 0, 0); rk5 = rk4;
#define BAT_KOFF(i) ((unsigned)(((tid + 256 * (i)) / KCH) * ldk + ((tid + 256 * (i)) % KCH) * 8) * 2u)
#define BAT_VOFF(i) ((unsigned)(((tid + 256 * (i)) >> 3) * ldv + ((tid + 256 * (i)) & 7) * 8) * 2u)
#define BAT_KLDS(i) (sK + ((tid + 256 * (i)) / KCH) * KROWB + ((tid + 256 * (i)) % KCH) * 16)
#define BAT_VLDS(i) (sV + ((tid + 256 * (i)) >> 3) * AV_ROWB + ((tid + 256 * (i)) & 7) * 16)
#define BAT_LOADG(kt_)                                                                   \
  {                                                                                     \
    const char* kb_ = (const char*)(K + (size_t)(kt_) * 64 * ldk);                      \
    const char* vb_ = (const char*)(Vt + (size_t)(kt_) * vts);                          \
    rk0 = *(const uint4*)(kb_ + BAT_KOFF(0)); rk1 = *(const uint4*)(kb_ + BAT_KOFF(1));   \
    rk2 = *(const uint4*)(kb_ + BAT_KOFF(2)); rk3 = *(const uint4*)(kb_ + BAT_KOFF(3));   \
    if (NKL > 4) { rk4 = *(const uint4*)(kb_ + BAT_KOFF(4)); rk5 = *(const uint4*)(kb_ + BAT_KOFF(5)); } \
    rv0 = *(const uint4*)(vb_ + BAT_VOFF(0)); rv1 = *(const uint4*)(vb_ + BAT_VOFF(1));   \
    rv2 = *(const uint4*)(vb_ + BAT_VOFF(2)); rv3 = *(const uint4*)(vb_ + BAT_VOFF(3));   \
  }
#define BAT_VST(i, v)                                                    \
  {                                                                     \
    *(uint2*)(BAT_VLDS(i)) = make_uint2(v.x, v.y);                       \
    *(uint2*)(BAT_VLDS(i) + 8) = make_uint2(v.z, v.w);                   \
  }
#define BAT_STOREL()                                                                     \
  {                                                                                     \
    *(uint4*)(BAT_KLDS(0)) = rk0; *(uint4*)(BAT_KLDS(1)) = rk1;                           \
    *(uint4*)(BAT_KLDS(2)) = rk2; *(uint4*)(BAT_KLDS(3)) = rk3;                           \
    if (NKL > 4) { *(uint4*)(BAT_KLDS(4)) = rk4; *(uint4*)(BAT_KLDS(5)) = rk5; }          \
    BAT_VST(0, rv0) BAT_VST(1, rv1) BAT_VST(2, rv2) BAT_VST(3, rv3)                         \
  }

  BAT_LOADG(kt0);
  BAT_STOREL();
  __syncthreads();
  for (int kt = kt0; kt < kt1; ++kt) {
    if (kt + 1 < kt1) BAT_LOADG(kt + 1);
    __builtin_amdgcn_sched_barrier(0);
    __builtin_amdgcn_s_setprio(1);
#pragma unroll
    for (int kh = 0; kh < 2; ++kh) {
      const int k0 = kt * 64 + kh * 32;
      f32x16 sc = zero16();
#pragma unroll
      for (int ks = 0; ks < NKS; ++ks) {
        bf16x8 a0 = *(const bf16x8*)(sK + (kh * 32 + r) * KROWB + ks * 32 + h * 16);
        sc = MFMA(a0, qf[ks], sc);
      }
      if (CAUSAL) {
        if (k0 + 31 > q0 + wave * 32) {
#pragma unroll
          for (int q = 0; q < 16; ++q) {
            int key = k0 + crow(q, h);
            if (key > qrow) sc[q] = -INFINITY;
          }
        }
      }
      float mx = sc[0];
#pragma unroll
      for (int q = 1; q < 16; ++q) mx = fmaxf(mx, sc[q]);
      {
        auto sw = __builtin_amdgcn_permlane32_swap(__float_as_uint(mx), __float_as_uint(mx), false, false);
        mx = fmaxf(__uint_as_float(sw[0]), __uint_as_float(sw[1]));
      }
      if (__builtin_amdgcn_ballot_w64(mx > m_run + 8.f) != 0ull) {
        const float m_new = fmaxf(m_run, mx);
        const float m_safe = (m_new == -INFINITY) ? 0.f : m_new;
        const float alpha = __builtin_amdgcn_exp2f(m_run - m_safe);
        m_run = m_new;
        l_run *= alpha;
#pragma unroll
        for (int dt = 0; dt < 4; ++dt)
#pragma unroll
          for (int q = 0; q < 16; ++q) oacc[dt][q] *= alpha;
      }
      const float m_ref = (m_run == -INFINITY) ? 0.f : m_run;
      float ls = 0.f;
#pragma unroll
      for (int q = 0; q < 16; ++q) { sc[q] = __builtin_amdgcn_exp2f(sc[q] - m_ref); ls += sc[q]; }
      l_run += ls;
#pragma unroll
      for (int s2 = 0; s2 < 2; ++s2) {
        bf16x8 pb = pack8(sc, s2);
#pragma unroll
        for (int dt = 0; dt < 4; ++dt) {
          const char* vp = sV + (dt * 32 + r) * AV_ROWB + (32 * kh + 16 * s2 + 4 * h) * 2;
          uint2 lo = *(const uint2*)vp;
          uint2 hi = *(const uint2*)(vp + 16);
          uint4 av = make_uint4(lo.x, lo.y, hi.x, hi.y);
          oacc[dt] = MFMA(__builtin_bit_cast(bf16x8, av), pb, oacc[dt]);
        }
      }
      __builtin_amdgcn_sched_barrier(0);
    }
    __builtin_amdgcn_s_setprio(0);
    __syncthreads();
    if (kt + 1 < kt1) { BAT_STOREL(); }
    __syncthreads();
  }
  const float l = l_run + __shfl_xor(l_run, 32, 64);
  const float ca = 1.f / l;
  float ssq = 0.f;
#pragma unroll
  for (int dt = 0; dt < 4; ++dt)
#pragma unroll
    for (int g4 = 0; g4 < 4; ++g4) {
      float o0 = oacc[dt][4 * g4] * ca, o1 = oacc[dt][4 * g4 + 1] * ca, o2 = oacc[dt][4 * g4 + 2] * ca, o3 = oacc[dt][4 * g4 + 3] * ca;
      ssq += o0 * o0 + o1 * o1 + o2 * o2 + o3 * o3;
      uint2 u; u.x = pack2(o0, o1); u.y = pack2(o2, o3);
      *(uint2*)(Y + (size_t)qrow * ldy + dt * 32 + 8 * g4 + 4 * h) = u;
    }
  ssq += __shfl_xor(ssq, 32, 64);
  if (h == 0) atomicAdd(ssout + qrow, ssq);
}

__device__ void hg_output(const Params& P, int item, char* smem) {
  char* ws = P.ws;
  const int tid = threadIdx.x, lane = tid & 63, wave = tid >> 6, r = lane & 31, h = lane >> 5;
  const int bh = item >> 7, c = item & 127, b = bh >> 2, hh = bh & 3;
  const int t0 = b * SEQ + c * 64;
  char* sq = smem;
  char* sk = smem + 64 * QK_ROWB;
  char* svT = smem + 128 * QK_ROWB;
  float* ssum = (float*)(smem + 128 * QK_ROWB + 128 * VT_ROWB);
  {
    const bf16_t* src = (const bf16_t*)(ws + OFF_PROJH) + (size_t)t0 * LD_PH + hh * 128;
    hg_tile_to_lds(src, sq);
    hg_tile_to_lds(src + 512, sk);
    hg_build_vT(src + 1024, svT);
  }
  __syncthreads();
  if (tid < 128) {
    const int d = tid;
    const float lb = ((const float*)(ws + OFF_LB))[hh * 128 + d];
    float bc = 0.f;
    for (int t8 = 0; t8 < 64; t8 += 8) {
      float qv[8], fv[8];
#pragma unroll
      for (int i = 0; i < 8; ++i) {
        qv[i] = bf2f(*(const bf16_t*)(sq + (t8 + i) * QK_ROWB + d * 2));
        fv[i] = bf2f(*(const bf16_t*)(sk + (t8 + i) * QK_ROWB + d * 2));
      }
#pragma unroll
      for (int i = 0; i < 8; ++i) {
        float f = lb + (1.f - lb) * sigmoidf_(fv[i]);
        bc += __builtin_amdgcn_logf(f);
        float qs = qv[i] * sigmoidf_(qv[i]) * 0.08838834764831845f * __builtin_amdgcn_exp2f(bc);
        float kx = (1.f - f) * __builtin_amdgcn_exp2f(-bc);
        *(bf16_t*)(sq + (t8 + i) * QK_ROWB + d * 2) = f2bf(qs);
        *(bf16_t*)(sk + (t8 + i) * QK_ROWB + d * 2) = f2bf(kx);
      }
    }
  }
  __syncthreads();
  const int tt = wave & 1, eh = wave >> 1;
  f32x16 x0 = zero16(), x1 = zero16();
#pragma unroll
  for (int ks = 0; ks < 8; ++ks) {
    bf16x8 bq = *(const bf16x8*)(sq + (tt * 32 + r) * QK_ROWB + ks * 32 + h * 16);
    bf16x8 a0 = *(const bf16x8*)(sk + r * QK_ROWB + ks * 32 + h * 16);
    x0 = MFMA(a0, bq, x0);
    if (tt == 1) {
      bf16x8 a1 = *(const bf16x8*)(sk + (32 + r) * QK_ROWB + ks * 32 + h * 16);
      x1 = MFMA(a1, bq, x1);
    }
  }
  if (tt == 0) {
#pragma unroll
    for (int q = 0; q < 16; ++q) if (crow(q, h) > r) x0[q] = 0.f;
  } else {
#pragma unroll
    for (int q = 0; q < 16; ++q) if (crow(q, h) > r) x1[q] = 0.f;
  }
  f32x16 o[2];
  o[0] = zero16(); o[1] = zero16();
  const int nst = (tt == 0) ? 2 : 4;
#pragma unroll
  for (int s = 0; s < 4; ++s) {
    if (s < nst) {
      bf16x8 pb = (s < 2) ? pack8(x0, s & 1) : pack8(x1, s & 1);
#pragma unroll
      for (int et = 0; et < 2; ++et) {
        const char* vp = svT + ((eh * 2 + et) * 32 + r) * VT_ROWB + (16 * s + 4 * h) * 2;
        uint2 lo = *(const uint2*)vp;
        uint2 hi = *(const uint2*)(vp + 16);
        uint4 av = make_uint4(lo.x, lo.y, hi.x, hi.y);
        o[et] = MFMA(__builtin_bit_cast(bf16x8, av), pb, o[et]);
      }
    }
  }
  const bf16_t* St = (const bf16_t*)(ws + OFF_L) + (size_t)(bh * 128 + c) * 16384;
#pragma unroll
  for (int ks = 0; ks < 8; ++ks) {
    bf16x8 bq = *(const bf16x8*)(sq + (tt * 32 + r) * QK_ROWB + ks * 32 + h * 16);
#pragma unroll
    for (int et = 0; et < 2; ++et) {
      bf16x8 a = *(const bf16x8*)(St + ((eh * 2 + et) * 32 + r) * 128 + ks * 16 + h * 8);
      o[et] = MFMA(a, bq, o[et]);
    }
  }
  float ssq = 0.f;
#pragma unroll
  for (int et = 0; et < 2; ++et)
#pragma unroll
    for (int q = 0; q < 16; ++q) ssq += o[et][q] * o[et][q];
  ssq += __shfl_xor(ssq, 32, 64);
  if (h == 0) ssum[eh * 64 + tt * 32 + r] = ssq;
  __syncthreads();
  const float tot = ssum[tt * 32 + r] + ssum[64 + tt * 32 + r];
  const float rstd = rsqrtf(tot * (1.f / 128.f) + EPS);
  bf16_t* gp = (bf16_t*)(ws + OFF_PROJH) + (size_t)(t0 + tt * 32 + r) * LD_PH + 1536 + hh * 128;
#pragma unroll
  for (int et = 0; et < 2; ++et)
#pragma unroll
    for (int g4 = 0; g4 < 4; ++g4) {
      const int e = (eh * 2 + et) * 32 + 8 * g4 + 4 * h;
      uint2 gu = *(const uint2*)(gp + e);
      float4 gn = *(const float4*)(P.hg_out_norm + hh * 128 + e);
      float g0 = lo2f(gu.x), g1 = hi2f(gu.x), g2 = lo2f(gu.y), g3 = hi2f(gu.y);
      float y0 = o[et][4 * g4] * rstd * gn.x * g0 * sigmoidf_(g0);
      float y1 = o[et][4 * g4 + 1] * rstd * gn.y * g1 * sigmoidf_(g1);
      float y2 = o[et][4 * g4 + 2] * rstd * gn.z * g2 * sigmoidf_(g2);
      float y3 = o[et][4 * g4 + 3] * rstd * gn.w * g3 * sigmoidf_(g3);
      uint2 u; u.x = pack2(y0, y1); u.y = pack2(y2, y3);
      *(uint2*)(gp + e) = u;
    }
  __syncthreads();
}

DI int next_item(unsigned* cnt, int* s_item) {
  if (threadIdx.x == 0) *s_item = (int)atomicAdd(cnt, 1u);
  __syncthreads();
  const int item = *s_item;
  __syncthreads();
  return item;
}
__device__ void phase4(const Params& P, char* smem) {
  char* ws = P.ws;
  __shared__ int s_item;
  unsigned* cnt = (unsigned*)(ws + OFF_CNT);
  constexpr int N_MLA = 1024, N_MEM = 1024, N_H3 = 1024;
  while (true) {
    const int item = next_item(cnt, &s_item);
    if (item >= N_MLA) break;
    const int qt = 127 - (item >> 3), bh = item & 7, b = bh >> 2, hh = bh & 3;
    attn_item<192, true>((const bf16_t*)(ws + OFF_Q) + (size_t)b * SEQ * 768 + hh * 192, 768,
                         (const bf16_t*)(ws + OFF_K) + (size_t)bh * SEQ * 192, 192,
                         (const bf16_t*)(ws + OFF_VT) + (size_t)bh * 128 * 8192, 64, 8192, qt * 64, 0,
                         (bf16_t*)(ws + OFF_YMLA) + (size_t)b * SEQ * LD_YMLA + hh * 128, LD_YMLA,
                         (float*)(ws + OFF_SS) + b * SEQ, smem);
  }
  while (true) {
    const int u = next_item(cnt + 1, &s_item);
    if (u >= N_MEM / 2) break;
    const int bh = u & 7, qt = u >> 3, b = bh >> 2, hh = bh & 3;
    bf16_t* qp = (bf16_t*)(ws + OFF_PROJM) + (size_t)b * SEQ * LD_PM + hh * 128;
    attn_item128<128, false>(qp, LD_PM, (const bf16_t*)(ws + OFF_KMEM) + (size_t)bh * 256 * 128, 128,
                             (const bf16_t*)(ws + OFF_VMEMT) + (size_t)bh * 128 * 256, 256, 64, qt * 128, 0, 4, qp, LD_PM,
                             (float*)(ws + OFF_SS) + T_TOK + b * SEQ, smem);
  }
  while (true) {
    const int u = next_item(cnt + 2, &s_item);
    if (u >= N_H3) break;
    hg_output(P, u, smem);
  }
}

__device__ void phase5(const Params& P, int bid, int nb, char* smem) {
  char* ws = P.ws;
  GArgs g;
  g.A0 = (const bf16_t*)(ws + OFF_YMLA); g.lda0 = LD_YMLA; g.kb0 = 0;
  g.A1 = (const bf16_t*)(ws + OFF_PROJM); g.lda1 = LD_PM; g.kb1 = 1024;
  g.A2 = (const bf16_t*)(ws + OFF_PROJH) + 1536; g.lda2 = LD_PH; g.kb2 = 512;
  g.segIters = 8; g.nIter = 24; g.Ktot = 1536; g.Bt = (const bf16_t*)(ws + OFF_WT_OUT); g.ldb = LD_WOUT;
  for (int t = bid; t < 64 * 8; t += nb) { int mt, nt; tile_mn(t, 8, mt, nt); gemm_tile<EPI_OUT>(P, g, mt * 256, nt * 128, smem); }
}
__device__ void phase6(const Params& P, int bid, int nb, char* smem) {
  char* ws = P.ws;
  GArgs g = garg1((const bf16_t*)(ws + OFF_X1B), LD_XB, 1024, (const bf16_t*)(ws + OFF_WT_GU), LD_WGU);
  for (int t = bid; t < 64 * 44; t += nb) { int mt, nt; tile_mn(t, 44, mt, nt); gemm_tile<EPI_GU>(P, g, mt * 256, nt * 128, smem); }
}
__device__ void phase7(const Params& P, int bid, int nb, char* smem) {
  char* ws = P.ws;
  GArgs g = garg1((const bf16_t*)(ws + OFF_ACT), LD_ACT, 2816, (const bf16_t*)(ws + OFF_WT_DN), LD_WDN);
  for (int t = bid; t < 64 * 8; t += nb) { int mt, nt; tile_mn(t, 8, mt, nt); gemm_tile<EPI_DOWN>(P, g, mt * 256, nt * 128, smem); }
}


#define XB_TMO      128
#define XB_XCNT(j)  (256  + 64 * (j))
#define XB_XSUB(j)  (1280 + 64 * (j))
#define XB_XGEN(j)  (2304 + 64 * (j))
#define XB_TOP      3328
#define XB_TOPGEN   3392
#define XCD_BAR_WORDS 3456
#define XB_SPIN_CAP (1u << 18)
#define LAS __attribute__((address_space(3)))
DI unsigned xb_ld(unsigned* p) { return __hip_atomic_load(p, __ATOMIC_RELAXED, __HIP_MEMORY_SCOPE_AGENT); }
DI unsigned xb_add(unsigned* p, unsigned v) { return __hip_atomic_fetch_add(p, v, __ATOMIC_RELAXED, __HIP_MEMORY_SCOPE_AGENT); }
DI unsigned xb_xcc_id() { return (unsigned)__builtin_amdgcn_s_getreg((3 << 11) | 20) & 0xFu; }
#define XB_SPIN(cond, bar) do { unsigned _sp = 0; while (cond) { __builtin_amdgcn_s_sleep(1); \
    if ((++_sp & 255u) == 0u) { if (xb_ld(&(bar)[XB_TMO])) break; if (_sp > XB_SPIN_CAP) { atomicAdd(&(bar)[XB_TMO], 1u); break; } } } } while (0)
struct XcdBarrier { unsigned* bar; unsigned x; volatile LAS unsigned* st; };
DI XcdBarrier xcd_barrier_post(unsigned* bar, volatile LAS unsigned* st) {
  XcdBarrier b; b.bar = bar; b.x = xb_xcc_id(); b.st = st;
  if (threadIdx.x == 0) (void)xb_add(&bar[XB_XCNT(b.x)], 1u);
  return b;
}
DI void xcd_barrier_complete(unsigned* bar, unsigned x, unsigned& nloc, unsigned& nx) {
  const unsigned G = gridDim.x * gridDim.y * gridDim.z;
  unsigned sum, cnt, mine, sp = 0u;
  for (;;) {
    sum = 0u; cnt = 0u; mine = 0u;
#pragma unroll
    for (unsigned j = 0; j < 16; ++j) { const unsigned c = xb_ld(&bar[XB_XCNT(j)]); sum += c; cnt += (c > 0u) ? 1u : 0u; mine = (j == x) ? c : mine; }
    if (sum == G) break;
    __builtin_amdgcn_s_sleep(1);
    if ((++sp & 255u) == 0u) { if (xb_ld(&bar[XB_TMO])) break; if (sp > XB_SPIN_CAP) { atomicAdd(&bar[XB_TMO], 1u); break; } }
  }
  nloc = mine > 0u ? mine : 1u; nx = cnt > 0u ? cnt : 1u;
}
DI void xcd_barrier(const XcdBarrier& b) {
  asm volatile("s_waitcnt vmcnt(0)" ::: "memory");
  __syncthreads();
  if (threadIdx.x == 0) {
    unsigned* bar = b.bar;
    __builtin_amdgcn_s_waitcnt(0);
    unsigned nloc = b.st[0], nx = b.st[1];
    if (nloc == 0u) { xcd_barrier_complete(bar, b.x, nloc, nx); b.st[0] = nloc; b.st[1] = nx; }
    const unsigned old = xb_add(&bar[XB_XSUB(b.x)], 1u);
    const unsigned gen = old / nloc;
    if (old + 1u == (gen + 1u) * nloc) {
      __builtin_amdgcn_fence(__ATOMIC_RELEASE, "agent");
      asm volatile("s_waitcnt vmcnt(0)" ::: "memory");
      const unsigned og = xb_add(&bar[XB_TOP], 1u);
      const unsigned tg = og / nx;
      if (og + 1u == (tg + 1u) * nx) xb_add(&bar[XB_TOPGEN], 1u);
      else XB_SPIN(xb_ld(&bar[XB_TOPGEN]) == tg, bar);
      __builtin_amdgcn_fence(__ATOMIC_ACQUIRE, "agent");
      xb_add(&bar[XB_XGEN(b.x)], 1u);
      asm volatile("s_waitcnt vmcnt(0)" ::: "memory");
    } else {
      XB_SPIN(xb_ld(&bar[XB_XGEN(b.x)]) == gen, bar);
      __builtin_amdgcn_fence(__ATOMIC_ACQUIRE, "agent");
      asm volatile("s_waitcnt vmcnt(0)" ::: "memory");
    }
  }
  __syncthreads();
}

#if MEGA
__global__ void __launch_bounds__(256, 2) fwd_megakernel(Params P) {
  __shared__ __attribute__((aligned(16))) char smem[SMEM_BYTES];
  __shared__ uint4 xb_words;
  cg::grid_group grid = cg::this_grid();
  if (P.ws == nullptr) grid.sync();
  if (threadIdx.x == 0) xb_words = make_uint4(0u, 0u, 0u, 0u);
  __syncthreads();
  const XcdBarrier xb = xcd_barrier_post((unsigned*)(P.ws + OFF_BAR), (volatile LAS unsigned*)&xb_words);
  const int bid = blockIdx.x, nb = gridDim.x;
  phase0(P, bid, nb, smem); xcd_barrier(xb);
  phase1(P, bid, nb, smem); xcd_barrier(xb);
  phase2(P, bid, nb, smem); xcd_barrier(xb);
  phase3(P, bid, nb, smem); xcd_barrier(xb);
  phase4(P, smem); xcd_barrier(xb);
  phase5(P, bid, nb, smem); xcd_barrier(xb);
  phase6(P, bid, nb, smem); xcd_barrier(xb);
  phase7(P, bid, nb, smem);
}
#else
#define PHASE_KERNEL(NAME, CALL)                                             \
  __global__ void __launch_bounds__(256, 2) NAME(Params P) {                 \
    __shared__ __attribute__((aligned(16))) char smem[SMEM_BYTES];           \
    const int bid = blockIdx.x, nb = gridDim.x; (void)bid; (void)nb;         \
    CALL;                                                                    \
  }
PHASE_KERNEL(k_p0, phase0(P, bid, nb, smem))
PHASE_KERNEL(k_p1, phase1(P, bid, nb, smem))
PHASE_KERNEL(k_p2, phase2(P, bid, nb, smem))
PHASE_KERNEL(k_p3, phase3(P, bid, nb, smem))
PHASE_KERNEL(k_p4, phase4(P, smem))
PHASE_KERNEL(k_p5, phase5(P, bid, nb, smem))
PHASE_KERNEL(k_p6, phase6(P, bid, nb, smem))
PHASE_KERNEL(k_p7, phase7(P, bid, nb, smem))
#endif

extern "C" void kernel_launch(void* const* d_in, const int* in_sizes, int n_in, void* d_out, int out_size, void* d_ws,
                              size_t ws_size, hipStream_t stream) {
  Params p{};
  p.x = (const float*)d_in[0]; p.mem = (const float*)d_in[1]; p.pos = (const int*)d_in[2];
  p.norm_mix = (const float*)d_in[3]; p.norm_mem = (const float*)d_in[4]; p.w_in = (const float*)d_in[5];
  p.q_a_norm = (const float*)d_in[6]; p.w_uq = (const float*)d_in[7]; p.kv_a_norm = (const float*)d_in[8];
  p.w_ukv = (const float*)d_in[9]; p.mla_q_norm = (const float*)d_in[10]; p.mla_k_norm = (const float*)d_in[11];
  p.lb_logits = (const float*)d_in[12]; p.hg_out_norm = (const float*)d_in[13]; p.w_mem_kv = (const float*)d_in[14];
  p.mem_q_norm = (const float*)d_in[15]; p.mem_k_norm = (const float*)d_in[16]; p.mla_out_norm = (const float*)d_in[17];
  p.mem_out_norm = (const float*)d_in[18]; p.w_out = (const float*)d_in[19]; p.norm_ffn = (const float*)d_in[20];
  p.w_gate = (const float*)d_in[21]; p.w_up = (const float*)d_in[22]; p.w_down = (const float*)d_in[23];
  p.out = (float*)d_out; p.ws = (char*)d_ws;
  for (int i = 0; i < 32; ++i) p.inv_freq[i] = std::pow(10000.0, -(double)i / 32.0);
#if MEGA
  static int grid_blocks = 0;
  if (!grid_blocks) {
    int dev = 0, cus = 0, per_cu = 0;
    hipGetDevice(&dev);
    hipDeviceGetAttribute(&cus, hipDeviceAttributeMultiprocessorCount, dev);
    hipOccupancyMaxActiveBlocksPerMultiprocessor(&per_cu, fwd_megakernel, 256, 0);
    if (per_cu > 2) per_cu = 2;
    if (per_cu < 1) per_cu = 1;
    grid_blocks = cus * per_cu;
  }
  void* args[] = {&p};
  (void)hipMemsetAsync((char*)d_ws + OFF_BAR, 0, XCD_BAR_WORDS * sizeof(unsigned), stream);
  hipError_t e = hipLaunchCooperativeKernel((void*)fwd_megakernel, dim3(grid_blocks), dim3(256), args, 0, stream);
  if (e != hipSuccess) fprintf(stderr, "cooperative launch failed: %s (grid %d)\n", hipGetErrorString(e), grid_blocks);
#else
  const int G = 512;
  k_p0<<<G, 256, 0, stream>>>(p);
  k_p1<<<G, 256, 0, stream>>>(p);
  k_p2<<<G, 256, 0, stream>>>(p);
  k_p3<<<G, 256, 0, stream>>>(p);
  k_p4<<<G, 256, 0, stream>>>(p);
  k_p5<<<G, 256, 0, stream>>>(p);
  k_p6<<<G, 256, 0, stream>>>(p);
  k_p7<<<G, 256, 0, stream>>>(p);
#endif
}
```

```cpp
#include <hip/hip_runtime.h>
#include <hip/hip_cooperative_groups.h>
#include <stdint.h>
#include <cmath>
#include <cstdio>
namespace cg = cooperative_groups;

#ifndef MEGA
#define MEGA 1
#endif

typedef unsigned short bf16_t;
using bf16x8 = __attribute__((ext_vector_type(8))) short;
using f32x16 = __attribute__((ext_vector_type(16))) float;
#define DI __device__ __forceinline__
#define MFMA(a, b, c) __builtin_amdgcn_mfma_f32_32x32x16_bf16((a), (b), (c), 0, 0, 0)

constexpr int T_TOK = 16384, SEQ = 8192;
constexpr float EPS = 1e-6f;
constexpr float LOG2E = 1.4426950408889634f;

constexpr size_t MiB = 1ull << 20;
constexpr int LD_WIN = 1088, LD_WUQ = 448, LD_WUKV = 320, LD_WMKV = 1088, LD_WOUT = 1600, LD_WGU = 1088, LD_WDN = 2880;
constexpr int LD_XB = 1088, LD_PH = 2112, LD_PM = 576, LD_YMLA = 576, LD_VT = 8256, LD_ACT = 2880;
constexpr size_t OFF_WT_IN = 0;
constexpr size_t OFF_WT_UQ = OFF_WT_IN + 3328ull * LD_WIN * 2;
constexpr size_t OFF_WT_UKV = OFF_WT_UQ + 768ull * LD_WUQ * 2;
constexpr size_t OFF_WT_MKV = OFF_WT_UKV + 1024ull * LD_WUKV * 2;
constexpr size_t OFF_WT_OUT = OFF_WT_MKV + 1024ull * LD_WMKV * 2;
constexpr size_t OFF_WT_GU = OFF_WT_OUT + 1024ull * LD_WOUT * 2;
constexpr size_t OFF_WT_DN = OFF_WT_GU + 5632ull * LD_WGU * 2;
constexpr size_t OFF_WT_END = OFF_WT_DN + 1024ull * LD_WDN * 2;
constexpr size_t OFF_SMALL = 31 * MiB;
static_assert(OFF_WT_END <= OFF_SMALL, "weights overflow");
constexpr size_t OFF_R0 = OFF_SMALL;
constexpr size_t OFF_RM = OFF_R0 + 65536;
constexpr size_t OFF_LB = OFF_RM + 2048;
constexpr size_t OFF_CNT = OFF_LB + 2048;
constexpr size_t OFF_SS = OFF_CNT + 256;
constexpr size_t OFF_COS = OFF_SS + 3 * 65536;
constexpr size_t OFF_SIN = OFF_COS + 2 * MiB;
constexpr size_t OFF_MEMB = OFF_SIN + 2 * MiB;
constexpr size_t OFF_MEMKV = OFF_MEMB + 1 * MiB;
constexpr size_t OFF_KMEM = OFF_MEMKV + 2 * MiB;
constexpr size_t OFF_VMEMT = OFF_KMEM + 512 * 1024;
constexpr size_t OFF_DEC = OFF_VMEMT + 512 * 1024;
constexpr size_t OFF_BAR = OFF_DEC + 512 * 1024;
constexpr size_t OFF_SSL = OFF_BAR + 16384;
constexpr size_t OFF_PROJA = 40 * MiB;
static_assert(OFF_SSL + 2 * 65536 <= OFF_PROJA, "small region overflow (ssl)");
static_assert(OFF_BAR + 16384 <= OFF_PROJA, "small region overflow");
constexpr size_t OFF_YMLA = OFF_PROJA;
constexpr size_t OFF_XB = 62 * MiB;
constexpr size_t OFF_L = OFF_XB;
constexpr size_t OFF_PROJH = 96 * MiB;
constexpr size_t OFF_PROJM = 162 * MiB;
constexpr size_t OFF_Q = 180 * MiB;
constexpr size_t OFF_K = 204 * MiB;
constexpr size_t OFF_VT = 228 * MiB;
constexpr size_t OFF_X1B = OFF_Q;
constexpr size_t OFF_ACT = 40 * MiB;
static_assert(OFF_VT + 1024ull * LD_VT * 2 <= 256 * MiB, "ws overflow");

struct Params {
  const float* x; const float* mem; const int* pos;
  const float *norm_mix, *norm_mem, *w_in, *q_a_norm, *w_uq, *kv_a_norm, *w_ukv, *mla_q_norm, *mla_k_norm, *lb_logits,
      *hg_out_norm, *w_mem_kv, *mem_q_norm, *mem_k_norm, *mla_out_norm, *mem_out_norm, *w_out, *norm_ffn, *w_gate, *w_up, *w_down;
  float* out; char* ws;
  double inv_freq[32];
};

DI float bf2f(bf16_t b) { return __uint_as_float(((unsigned)b) << 16); }
typedef __bf16 bf2_t __attribute__((ext_vector_type(2)));
typedef float f2_t __attribute__((ext_vector_type(2)));
DI unsigned pack2(float a, float b) { f2_t v = {a, b}; return __builtin_bit_cast(unsigned, __builtin_convertvector(v, bf2_t)); }
DI bf16_t f2bf(float x) { return (bf16_t)(pack2(x, 0.f) & 0xffffu); }
DI float lo2f(unsigned u) { return __uint_as_float(u << 16); }
DI float hi2f(unsigned u) { return __uint_as_float(u & 0xffff0000u); }
DI int crow(int reg, int h) { return (reg & 3) + 8 * (reg >> 2) + 4 * h; }
DI float wave_sum(float v) {
  for (int o = 32; o >= 1; o >>= 1) v += __shfl_xor(v, o, 64);
  return v;
}
DI float sigmoidf_(float x) { return __builtin_amdgcn_rcpf(1.f + __expf(-x)); }
DI bf16x8 pack8(const f32x16& x, int s) {
  uint4 p;
  p.x = pack2(x[8 * s + 0], x[8 * s + 1]); p.y = pack2(x[8 * s + 2], x[8 * s + 3]);
  p.z = pack2(x[8 * s + 4], x[8 * s + 5]); p.w = pack2(x[8 * s + 6], x[8 * s + 7]);
  return __builtin_bit_cast(bf16x8, p);
}
DI f32x16 zero16() { f32x16 z; for (int i = 0; i < 16; ++i) z[i] = 0.f; return z; }

constexpr int SMEM_BYTES = 74752;

DI float wgain(const Params& P, int gmode, const float* g1, int k) {
  if (gmode == 0) return 1.f;
  if (gmode == 1) return g1[k];
  return k < 512 ? P.mla_out_norm[k] : (k < 1024 ? 1.f : P.mem_out_norm[k - 1024]);
}
__device__ void transpose_cvt_tile(const Params& P, const float* W, int N, const float* g1, int gmode, bf16_t* Wt, int ldt,
                                   int rowmode, int kt, int nt, char* smem) {
  float(*tile)[65] = (float(*)[65])smem;
  const int tid = threadIdx.x, k0 = kt * 64, n0 = nt * 64;
  for (int i = 0; i < 16; ++i) {
    int idx = tid + 256 * i, kk = idx >> 6, nn = idx & 63;
    float v = 0.f;
    if (n0 + nn < N) v = W[(size_t)(k0 + kk) * N + n0 + nn] * wgain(P, gmode, g1, k0 + kk);
    tile[kk][nn] = v;
  }
  __syncthreads();
  for (int i = 0; i < 16; ++i) {
    int idx = tid + 256 * i, nn = idx >> 6, kk = idx & 63;
    int n = n0 + nn;
    int dr = rowmode == 0 ? n : ((n >> 5) * 64 + (n & 31) + (rowmode == 2 ? 32 : 0));
    Wt[(size_t)dr * ldt + k0 + kk] = f2bf(tile[kk][nn]);
  }
  __syncthreads();
}

__device__ void prep_transpose_job(const Params& P, int j, char* smem) {
  char* ws = P.ws;
  if (j < 832) { transpose_cvt_tile(P, P.w_in, 3264, P.norm_mix, 1, (bf16_t*)(ws + OFF_WT_IN), LD_WIN, 0, j / 52, j % 52, smem); return; }
  j -= 832;
  if (j < 72) { transpose_cvt_tile(P, P.w_uq, 768, P.q_a_norm, 1, (bf16_t*)(ws + OFF_WT_UQ), LD_WUQ, 0, j / 12, j % 12, smem); return; }
  j -= 72;
  if (j < 64) { transpose_cvt_tile(P, P.w_ukv, 1024, P.kv_a_norm, 1, (bf16_t*)(ws + OFF_WT_UKV), LD_WUKV, 0, j / 16, j % 16, smem); return; }
  j -= 64;
  if (j < 256) { transpose_cvt_tile(P, P.w_mem_kv, 1024, P.norm_mem, 1, (bf16_t*)(ws + OFF_WT_MKV), LD_WMKV, 0, j / 16, j % 16, smem); return; }
  j -= 256;
  if (j < 384) { transpose_cvt_tile(P, P.w_out, 1024, nullptr, 2, (bf16_t*)(ws + OFF_WT_OUT), LD_WOUT, 0, j / 16, j % 16, smem); return; }
  j -= 384;
  if (j < 704) { transpose_cvt_tile(P, P.w_gate, 2816, P.norm_ffn, 1, (bf16_t*)(ws + OFF_WT_GU), LD_WGU, 1, j / 44, j % 44, smem); return; }
  j -= 704;
  if (j < 704) { transpose_cvt_tile(P, P.w_up, 2816, P.norm_ffn, 1, (bf16_t*)(ws + OFF_WT_GU), LD_WGU, 2, j / 44, j % 44, smem); return; }
  j -= 704;
  transpose_cvt_tile(P, P.w_down, 1024, nullptr, 0, (bf16_t*)(ws + OFF_WT_DN), LD_WDN, 0, j / 16, j % 16, smem);
}

__device__ void phase0(const Params& P, int bid, int nb, char* smem) {
  char* ws = P.ws;
  const int tid = threadIdx.x, lane = tid & 63, wave = tid >> 6;
  constexpr int J_TR = 1224, J_ROWS = 4224, J_TAB = 2048, J_ZERO = 320, J_LB = 2;
  constexpr int J_TOTAL = J_TR + J_ROWS + J_TAB + J_ZERO + J_LB;
  for (int job = bid; job < J_TOTAL; job += nb) {
    if (job < J_TR) { prep_transpose_job(P, job, smem); continue; }
    int j = job - J_TR;
    if (j < J_ROWS) {
      int row = j * 4 + wave;
      const float* src; bf16_t* dst; float* rdst;
      if (row < T_TOK) { src = P.x + (size_t)row * 1024; dst = (bf16_t*)(ws + OFF_XB) + (size_t)row * LD_XB; rdst = (float*)(ws + OFF_R0) + row; }
      else { int r2 = row - T_TOK; src = P.mem + (size_t)r2 * 1024; dst = (bf16_t*)(ws + OFF_MEMB) + (size_t)r2 * 1024; rdst = (float*)(ws + OFF_RM) + r2; }
      float ss = 0.f;
      float4 v[4];
      for (int i = 0; i < 4; ++i) { v[i] = *(const float4*)(src + (i * 64 + lane) * 4); ss += v[i].x * v[i].x + v[i].y * v[i].y + v[i].z * v[i].z + v[i].w * v[i].w; }
      ss = wave_sum(ss);
      for (int i = 0; i < 4; ++i) { uint2 o; o.x = pack2(v[i].x, v[i].y); o.y = pack2(v[i].z, v[i].w); *(uint2*)(dst + (i * 64 + lane) * 4) = o; }
      if (lane == 0) *rdst = rsqrtf(ss * (1.f / 1024.f) + EPS);
      continue;
    }
    j -= J_ROWS;
    if (j < J_TAB) {
      int idx = j * 256 + tid;
      int t = idx >> 5, i = idx & 31;
      double ang = (double)P.pos[t] * P.inv_freq[i];
      double rev = ang * 0.15915494309189535;
      double fr = rev - rint(rev);
      float f = (float)fr;
      ((float*)(ws + OFF_COS))[idx] = __builtin_amdgcn_cosf(f);
      ((float*)(ws + OFF_SIN))[idx] = __builtin_amdgcn_sinf(f);
      continue;
    }
    j -= J_TAB;
    if (j < J_ZERO) { if (j < 192) ((float*)(ws + OFF_SS))[j * 256 + tid] = 0.f; else ((float*)(ws + OFF_SSL))[(j - 192) * 256 + tid] = 0.f; continue; }
    j -= J_ZERO;
    {
      int c = j * 256 + tid;
      float l0 = P.lb_logits[c], l1 = P.lb_logits[512 + c];
      ((float*)(ws + OFF_LB))[c] = 1.f / (1.f + __expf(l1 - l0));
      if (c < 4) ((unsigned*)(ws + OFF_CNT))[c] = 0u;
    }
  }
}

enum { EPI_PROJ = 0, EPI_MEMKV, EPI_Q, EPI_KV, EPI_OUT, EPI_GU, EPI_DOWN };
constexpr int G_ROWB = 144;
constexpr int G_ATILE = 256 * G_ROWB;
constexpr int G_STAGE = 384 * G_ROWB;
constexpr int LDS_RS = G_STAGE;
constexpr int CW_LD = 68;
constexpr int CW_BYTES = 32 * CW_LD * 4;

struct GArgs {
  const bf16_t *A0, *A1, *A2; int lda0, lda1, lda2; int kb0, kb1, kb2;
  int segIters, nIter, Ktot;
  const bf16_t* Bt; int ldb;
};

template <int EPI>
__device__ __forceinline__ void gemm_tile(const Params& P, const GArgs& g, int m0, int n0, char* smem) {
  const int tid = threadIdx.x, lane = tid & 63, wave = tid >> 6, r = lane & 31, h = lane >> 5;
  const int wm = wave >> 1, wn = wave & 1;
  char* ws = P.ws;
  float* rs = (float*)(smem + LDS_RS);
  float* f3 = rs + 256;

  if (EPI == EPI_Q || EPI == EPI_KV) {
    const float ssv = ((const float*)(ws + OFF_SSL))[(EPI == EPI_KV ? T_TOK : 0) + m0 + tid];
    rs[tid] = rsqrtf(ssv / (float)g.Ktot + EPS);
  }
  if (EPI == EPI_PROJ) rs[tid] = ((const float*)(ws + OFF_R0))[m0 + tid];
  if (EPI == EPI_MEMKV) rs[tid] = ((const float*)(ws + OFF_RM))[m0 + tid];
  if (EPI == EPI_GU) rs[tid] = rsqrtf(((const float*)(ws + OFF_SS))[2 * T_TOK + m0 + tid] * (1.f / 1024.f) + EPS);
  if (EPI == EPI_OUT) {
    const float* ssb = (const float*)(ws + OFF_SS);
    float r1 = rsqrtf(ssb[m0 + tid] * (1.f / 512.f) + EPS);
    float r3 = rsqrtf(ssb[T_TOK + m0 + tid] * (1.f / 512.f) + EPS);
    rs[tid] = r1 / r3; f3[tid] = r3;
  }

  f32x16 acc[4][2];
#pragma unroll
  for (int i = 0; i < 4; ++i) { acc[i][0] = zero16(); acc[i][1] = zero16(); }

  typedef unsigned u32x4_t __attribute__((ext_vector_type(4)));
  u32x4_t ra0, ra1, ra2, ra3, ra4, ra5, ra6, ra7, rb0, rb1, rb2, rb3;
  const bf16_t* const gA0 = g.A0; const bf16_t* const gA1 = g.A1; const bf16_t* const gA2 = g.A2;
  const int glda0 = g.lda0, glda1 = g.lda1, glda2 = g.lda2, gkb0 = g.kb0, gkb1 = g.kb1, gkb2 = g.kb2;
  const int segIters = g.segIters, nIter = g.nIter, ldb = g.ldb;
  const bf16_t* const gBt = g.Bt;
  const int lrow = tid >> 3, lkc = tid & 7;
#define GM_GLD(dst, voff, sbase) asm volatile("global_load_dwordx4 %0, %1, %2" : "=v"(dst) : "v"(voff), "s"(sbase) : "memory")
#define GM_LOADG(it_)                                                                   \
  {                                                                                     \
    const int seg_ = ((it_) >= segIters) + ((it_) >= 2 * segIters);                     \
    const int kk_ = ((it_) - seg_ * segIters) * 64;                                     \
    const bf16_t* Ap_ = gA0; int lda_ = glda0, kb_ = gkb0;                              \
    if (seg_ == 1) { Ap_ = gA1; lda_ = glda1; kb_ = gkb1; }                             \
    if (seg_ == 2) { Ap_ = gA2; lda_ = glda2; kb_ = gkb2; }                             \
    const bf16_t* ab_ = Ap_ + (size_t)m0 * lda_ + kk_;                                  \
    const bf16_t* bb_ = gBt + (size_t)n0 * ldb + kb_ + kk_;                             \
    const unsigned oa_ = (unsigned)(lrow * lda_ + lkc * 8) * 2u, sa2_ = (unsigned)lda_ * 64u; \
    const unsigned ob_ = (unsigned)(lrow * ldb + lkc * 8) * 2u, sb2_ = (unsigned)ldb * 64u;   \
    GM_GLD(ra0, oa_, ab_); GM_GLD(ra1, oa_ + sa2_, ab_); GM_GLD(ra2, oa_ + 2u * sa2_, ab_); GM_GLD(ra3, oa_ + 3u * sa2_, ab_); \
    GM_GLD(ra4, oa_ + 4u * sa2_, ab_); GM_GLD(ra5, oa_ + 5u * sa2_, ab_); GM_GLD(ra6, oa_ + 6u * sa2_, ab_); GM_GLD(ra7, oa_ + 7u * sa2_, ab_); \
    GM_GLD(rb0, ob_, bb_); GM_GLD(rb1, ob_ + sb2_, bb_); GM_GLD(rb2, ob_ + 2u * sb2_, bb_); GM_GLD(rb3, ob_ + 3u * sb2_, bb_); \
  }
#define GM_WAIT0()                                                                      \
  asm volatile("s_waitcnt vmcnt(0)"                                                     \
               : "+v"(ra0), "+v"(ra1), "+v"(ra2), "+v"(ra3), "+v"(ra4), "+v"(ra5), "+v"(ra6), "+v"(ra7),     \
                 "+v"(rb0), "+v"(rb1), "+v"(rb2), "+v"(rb3) : : "memory")
#define GM_STOREL()                                                                     \
  {                                                                                     \
    char* sa_ = smem + lrow * G_ROWB + lkc * 16;                                        \
    char* sb_ = sa_ + G_ATILE;                                                          \
    *(u32x4_t*)(sa_) = ra0; *(u32x4_t*)(sa_ + 32 * G_ROWB) = ra1;                       \
    *(u32x4_t*)(sa_ + 64 * G_ROWB) = ra2; *(u32x4_t*)(sa_ + 96 * G_ROWB) = ra3;         \
    *(u32x4_t*)(sa_ + 128 * G_ROWB) = ra4; *(u32x4_t*)(sa_ + 160 * G_ROWB) = ra5;       \
    *(u32x4_t*)(sa_ + 192 * G_ROWB) = ra6; *(u32x4_t*)(sa_ + 224 * G_ROWB) = ra7;       \
    *(u32x4_t*)(sb_) = rb0; *(u32x4_t*)(sb_ + 32 * G_ROWB) = rb1;                       \
    *(u32x4_t*)(sb_ + 64 * G_ROWB) = rb2; *(u32x4_t*)(sb_ + 96 * G_ROWB) = rb3;         \
  }
#define GM_COMPUTE()                                                                    \
  {                                                                                     \
    const char* sa_ = smem + (wm * 128 + r) * G_ROWB + h * 16;                          \
    const char* sb_ = smem + G_ATILE + (wn * 64 + r) * G_ROWB + h * 16;                 \
    _Pragma("unroll") for (int ks = 0; ks < 4; ++ks) {                                  \
      bf16x8 b0 = *(const bf16x8*)(sb_ + ks * 32);                                      \
      bf16x8 b1 = *(const bf16x8*)(sb_ + 32 * G_ROWB + ks * 32);                        \
      _Pragma("unroll") for (int i = 0; i < 4; ++i) {                                   \
        bf16x8 a = *(const bf16x8*)(sa_ + i * 32 * G_ROWB + ks * 32);                   \
        acc[i][0] = MFMA(a, b0, acc[i][0]);                                             \
        acc[i][1] = MFMA(a, b1, acc[i][1]);                                             \
      }                                                                                 \
    }                                                                                   \
  }

  GM_LOADG(0);
  GM_WAIT0();
  GM_STOREL();
  __syncthreads();
  if (nIter > 1) GM_LOADG(1);
#pragma unroll 1
  for (int it = 0; it < nIter; ++it) {
    if (EPI == EPI_OUT) {
      if (it == segIters || it == 2 * segIters) {
        const float* fac = (it == segIters) ? rs : f3;
#pragma unroll
        for (int i = 0; i < 4; ++i)
#pragma unroll
          for (int q = 0; q < 16; ++q) {
            float f = fac[wm * 128 + i * 32 + crow(q, h)];
            acc[i][0][q] *= f; acc[i][1][q] *= f;
          }
      }
    }
    __builtin_amdgcn_s_setprio(1);
    GM_COMPUTE();
    __builtin_amdgcn_s_setprio(0);
    __syncthreads();
    if (it + 1 < nIter) {
      GM_WAIT0();
      GM_STOREL();
    }
    __syncthreads();
    if (it + 2 < nIter) GM_LOADG(it + 2);
  }

  float* Cw = (float*)(smem + wave * CW_BYTES);
  const int ncol0 = n0 + wn * 64;
#pragma unroll
  for (int i = 0; i < 4; ++i) {
    const int mrow0 = wm * 128 + i * 32;
#pragma unroll
    for (int j = 0; j < 2; ++j)
#pragma unroll
      for (int q = 0; q < 16; ++q) Cw[crow(q, h) * CW_LD + j * 32 + r] = acc[i][j][q];
    __builtin_amdgcn_fence(__ATOMIC_RELEASE, "wavefront");
    if (EPI == EPI_KV && ((ncol0 >> 7) & 1)) {
      const int hh = ncol0 >> 8, c = (ncol0 & 127) + lane;
      const int b = m0 >> 13, s0 = (m0 & (SEQ - 1)) + mrow0;
      bf16_t* vt = (bf16_t*)(ws + OFF_VT) + (((size_t)((b * 4 + hh) * 128 + (s0 >> 6))) * 128 + c) * 64 + (s0 & 63);
#pragma unroll
      for (int g8 = 0; g8 < 4; ++g8) {
        float v[8];
#pragma unroll
        for (int k = 0; k < 8; ++k) v[k] = Cw[(g8 * 8 + k) * CW_LD + lane] * rs[mrow0 + g8 * 8 + k];
        uint4 o; o.x = pack2(v[0], v[1]); o.y = pack2(v[2], v[3]); o.z = pack2(v[4], v[5]); o.w = pack2(v[6], v[7]);
        *(uint4*)(vt + g8 * 8) = o;
      }
    } else if (EPI == EPI_GU) {
      const int L8 = lane & 7, rs8 = lane >> 3;
#pragma unroll 2
      for (int p = 0; p < 4; ++p) {
        const int row = p * 8 + rs8, m = m0 + mrow0 + row;
        float4 v0 = *(const float4*)(Cw + row * CW_LD + 4 * L8);
        float4 v1 = *(const float4*)(Cw + row * CW_LD + 32 + 4 * L8);
        float s = rs[mrow0 + row];
        float gx[4] = {v0.x * s, v0.y * s, v0.z * s, v0.w * s};
        float ux[4] = {v1.x * s, v1.y * s, v1.z * s, v1.w * s};
        float a[4];
#pragma unroll
        for (int q = 0; q < 4; ++q) a[q] = gx[q] * sigmoidf_(gx[q]) * ux[q];
        uint2 u; u.x = pack2(a[0], a[1]); u.y = pack2(a[2], a[3]);
        *(uint2*)((bf16_t*)(ws + OFF_ACT) + (size_t)m * LD_ACT + (ncol0 >> 1) + 4 * L8) = u;
      }
    } else {
      const int L = lane & 15, rsub = lane >> 4;
      constexpr int UNR_ = (EPI == EPI_OUT || EPI == EPI_DOWN) ? 4 : 2;
#pragma clang loop unroll_count(UNR_)
      for (int p = 0; p < 8; ++p) {
        const int row = p * 4 + rsub, trow = mrow0 + row, m = m0 + trow;
        const int n = ncol0 + 4 * L;
        float4 v = *(const float4*)(Cw + row * CW_LD + 4 * L);
        if (EPI == EPI_PROJ) {
          float s = rs[trow];
          uint2 o; o.x = pack2(v.x * s, v.y * s); o.y = pack2(v.z * s, v.w * s);
          if (n < 704) *(uint2*)((bf16_t*)(ws + OFF_PROJA) + (size_t)m * 704 + n) = o;
          else if (n < 2752) *(uint2*)((bf16_t*)(ws + OFF_PROJH) + (size_t)m * LD_PH + (n - 704)) = o;
          else if (n < 3264) *(uint2*)((bf16_t*)(ws + OFF_PROJM) + (size_t)m * LD_PM + (n - 2752)) = o;
          if (ncol0 < 640) {
            float q0_ = lo2f(o.x), q1_ = hi2f(o.x), q2_ = lo2f(o.y), q3_ = hi2f(o.y);
            float ssq = q0_ * q0_ + q1_ * q1_ + q2_ * q2_ + q3_ * q3_;
            ssq += __shfl_xor(ssq, 1, 64); ssq += __shfl_xor(ssq, 2, 64); ssq += __shfl_xor(ssq, 4, 64); ssq += __shfl_xor(ssq, 8, 64);
            if (L == 0) atomicAdd((float*)(ws + OFF_SSL) + (ncol0 < 384 ? 0 : T_TOK) + m, ssq);
          }
        } else if (EPI == EPI_MEMKV) {
          float s = rs[trow];
          *(float4*)((float*)(ws + OFF_MEMKV) + (size_t)m * 1024 + n) = make_float4(v.x * s, v.y * s, v.z * s, v.w * s);
        } else if (EPI == EPI_Q) {
          float s = rs[trow];
          uint2 u; u.x = pack2(v.x * s, v.y * s); u.y = pack2(v.z * s, v.w * s);
          *(uint2*)((bf16_t*)(ws + OFF_Q) + (size_t)m * 768 + n) = u;
        } else if (EPI == EPI_KV) {
          float s = rs[trow];
          uint2 u; u.x = pack2(v.x * s, v.y * s); u.y = pack2(v.z * s, v.w * s);
          *(uint2*)((bf16_t*)(ws + OFF_K) + ((size_t)((m >> 13) * 4 + (n >> 8)) * SEQ + (m & (SEQ - 1))) * 192 + (n & 127)) = u;
        } else if (EPI == EPI_OUT) {
          float4 xin = *(const float4*)(P.x + (size_t)m * 1024 + n);
          float4 o = make_float4(xin.x + v.x, xin.y + v.y, xin.z + v.z, xin.w + v.w);
          *(float4*)(P.out + (size_t)m * 1024 + n) = o;
          uint2 u; u.x = pack2(o.x, o.y); u.y = pack2(o.z, o.w);
          *(uint2*)((bf16_t*)(ws + OFF_X1B) + (size_t)m * LD_XB + n) = u;
          float ssq = o.x * o.x + o.y * o.y + o.z * o.z + o.w * o.w;
          ssq += __shfl_xor(ssq, 1, 64); ssq += __shfl_xor(ssq, 2, 64); ssq += __shfl_xor(ssq, 4, 64); ssq += __shfl_xor(ssq, 8, 64);
          if (L == 0) atomicAdd((float*)(ws + OFF_SS) + 2 * T_TOK + m, ssq);
        } else if (EPI == EPI_DOWN) {
          float4 xin = *(const float4*)(P.out + (size_t)m * 1024 + n);
          *(float4*)(P.out + (size_t)m * 1024 + n) = make_float4(xin.x + v.x, xin.y + v.y, xin.z + v.z, xin.w + v.w);
        }
      }
    }
    __builtin_amdgcn_fence(__ATOMIC_ACQUIRE, "wavefront");
  }
  __syncthreads();
}

DI GArgs garg1(const bf16_t* A, int lda, int K, const bf16_t* Bt, int ldb) {
  GArgs g;
  g.A0 = g.A1 = g.A2 = A; g.lda0 = g.lda1 = g.lda2 = lda; g.kb0 = g.kb1 = g.kb2 = 0;
  g.segIters = K / 64; g.nIter = K / 64; g.Ktot = K; g.Bt = Bt; g.ldb = ldb;
  return g;
}

DI void tile_mn(int t, int NT, int& mt, int& nt) {
  int grp = t / (32 * NT), rem = t - grp * 32 * NT;
  nt = rem >> 5; mt = grp * 32 + (rem & 31);
}

__device__ void phase1(const Params& P, int bid, int nb, char* smem) {
  char* ws = P.ws;
  GArgs g1 = garg1((const bf16_t*)(ws + OFF_XB), LD_XB, 1024, (const bf16_t*)(ws + OFF_WT_IN), LD_WIN);
  GArgs g2 = garg1((const bf16_t*)(ws + OFF_MEMB), 1024, 1024, (const bf16_t*)(ws + OFF_WT_MKV), LD_WMKV);
  constexpr int NT1 = 64 * 26;
  for (int t = bid; t < NT1 + 16; t += nb) {
    if (t < NT1) { int mt, nt; tile_mn(t, 26, mt, nt); gemm_tile<EPI_PROJ>(P, g1, mt * 256, nt * 128, smem); }
    else { int u = t - NT1; gemm_tile<EPI_MEMKV>(P, g2, (u & 1) * 256, (u >> 1) * 128, smem); }
  }
  {
    const int rem = (NT1 + 16) % nb;
    const int first = rem == 0 ? 0 : rem, stride = nb - first;
    if (bid >= first)
      for (int u = bid - first; u < 2496; u += stride) prep_transpose_job(P, 1224 + u, smem);
  }
}

constexpr int VT_ROWB = 144;
constexpr int QK_ROWB = 272;
DI void hg_tile_to_lds(const bf16_t* src, char* dst) {
  const int tid = threadIdx.x;
  uint4 v0, v1, v2, v3;
  {
    const int t = tid >> 4, dc = tid & 15;
    const bf16_t* p = src + (size_t)t * LD_PH + dc * 8;
    v0 = *(const uint4*)(p); v1 = *(const uint4*)(p + (size_t)16 * LD_PH);
    v2 = *(const uint4*)(p + (size_t)32 * LD_PH); v3 = *(const uint4*)(p + (size_t)48 * LD_PH);
    char* d = dst + t * QK_ROWB + dc * 16;
    *(uint4*)(d) = v0; *(uint4*)(d + 16 * QK_ROWB) = v1; *(uint4*)(d + 32 * QK_ROWB) = v2; *(uint4*)(d + 48 * QK_ROWB) = v3;
  }
}
DI void hg_build_vT(const bf16_t* src, char* svT) {
  const int tid = threadIdx.x;
  const int t = tid & 63, dc0 = tid >> 6;
  uint4 v0, v1, v2, v3;
  const bf16_t* p = src + (size_t)t * LD_PH + dc0 * 8;
  v0 = *(const uint4*)(p); v1 = *(const uint4*)(p + 32); v2 = *(const uint4*)(p + 64); v3 = *(const uint4*)(p + 96);
#define HG_SCATTER(v, i)                                                        \
  {                                                                             \
    char* d = svT + ((dc0 + 4 * (i)) * 8) * VT_ROWB + t * 2;                    \
    *(bf16_t*)(d) = (bf16_t)(v.x & 0xffff); *(bf16_t*)(d + VT_ROWB) = (bf16_t)(v.x >> 16);             \
    *(bf16_t*)(d + 2 * VT_ROWB) = (bf16_t)(v.y & 0xffff); *(bf16_t*)(d + 3 * VT_ROWB) = (bf16_t)(v.y >> 16); \
    *(bf16_t*)(d + 4 * VT_ROWB) = (bf16_t)(v.z & 0xffff); *(bf16_t*)(d + 5 * VT_ROWB) = (bf16_t)(v.z >> 16); \
    *(bf16_t*)(d + 6 * VT_ROWB) = (bf16_t)(v.w & 0xffff); *(bf16_t*)(d + 7 * VT_ROWB) = (bf16_t)(v.w >> 16); \
  }
  HG_SCATTER(v0, 0) HG_SCATTER(v1, 1) HG_SCATTER(v2, 2) HG_SCATTER(v3, 3)
}

__device__ void hg_local_state(const Params& P, int item, char* smem) {
  char* ws = P.ws;
  const int tid = threadIdx.x, lane = tid & 63, wave = tid >> 6, r = lane & 31, h = lane >> 5;
  const int bh = item >> 7, c = item & 127, b = bh >> 2, hh = bh & 3;
  const int t0 = b * SEQ + c * 64;
  char* svT = smem;
  char* skT = smem + 128 * VT_ROWB;
  char* sraw = smem + 256 * VT_ROWB;
  const bf16_t* src = (const bf16_t*)(ws + OFF_PROJH) + (size_t)t0 * LD_PH + hh * 128;
  hg_tile_to_lds(src + 512, sraw);
  hg_build_vT(src + 1024, svT);
  __syncthreads();
  if (tid < 128) {
    const int d = tid;
    const float lb = ((const float*)(ws + OFF_LB))[hh * 128 + d];
    float run = 0.f;
    for (int j = 7; j >= 0; --j) {
      float v[8];
#pragma unroll
      for (int i = 7; i >= 0; --i) {
        float f = lb + (1.f - lb) * sigmoidf_(bf2f(*(const bf16_t*)(sraw + (8 * j + i) * QK_ROWB + d * 2)));
        v[i] = (1.f - f) * __builtin_amdgcn_exp2f(run);
        run += __builtin_amdgcn_logf(f);
      }
      uint4 o; o.x = pack2(v[0], v[1]); o.y = pack2(v[2], v[3]); o.z = pack2(v[4], v[5]); o.w = pack2(v[6], v[7]);
      *(uint4*)(skT + d * VT_ROWB + j * 16) = o;
    }
    ((float*)(ws + OFF_DEC))[(size_t)(bh * 128 + c) * 128 + d] = __builtin_amdgcn_exp2f(run);
  }
  __syncthreads();
  f32x16 acc[4];
  for (int i = 0; i < 4; ++i) acc[i] = zero16();
#pragma unroll
  for (int ks = 0; ks < 4; ++ks) {
    bf16x8 a = *(const bf16x8*)(svT + (wave * 32 + r) * VT_ROWB + ks * 32 + h * 16);
#pragma unroll
    for (int dt = 0; dt < 4; ++dt) {
      bf16x8 bb = *(const bf16x8*)(skT + (dt * 32 + r) * VT_ROWB + ks * 32 + h * 16);
      acc[dt] = MFMA(a, bb, acc[dt]);
    }
  }
  bf16_t* L = (bf16_t*)(ws + OFF_L) + (size_t)(bh * 128 + c) * 16384;
#pragma unroll
  for (int dt = 0; dt < 4; ++dt)
#pragma unroll
    for (int q = 0; q < 16; ++q) L[(wave * 32 + crow(q, h)) * 128 + dt * 32 + r] = f2bf(acc[dt][q]);
  __syncthreads();
}

__device__ void phase2(const Params& P, int bid, int nb, char* smem) {
  char* ws = P.ws;
  GArgs gq = garg1((const bf16_t*)(ws + OFF_PROJA), 704, 384, (const bf16_t*)(ws + OFF_WT_UQ), LD_WUQ);
  GArgs gkv = garg1((const bf16_t*)(ws + OFF_PROJA) + 384, 704, 256, (const bf16_t*)(ws + OFF_WT_UKV), LD_WUKV);
  constexpr int NQ = 64 * 6, NKV = 64 * 8, NH = 1024;
  for (int t = bid; t < NQ + NKV + NH; t += nb) {
    if (t < NQ) { int mt, nt; tile_mn(t, 6, mt, nt); gemm_tile<EPI_Q>(P, gq, mt * 256, nt * 128, smem); }
    else if (t < NQ + NKV) { int mt, nt; tile_mn(t - NQ, 8, mt, nt); gemm_tile<EPI_KV>(P, gkv, mt * 256, nt * 128, smem); }
    else hg_local_state(P, t - NQ - NKV, smem);
  }
}

__device__ void phase3(const Params& P, int bid, int nb, char* smem) {
  char* ws = P.ws;
  const int tid = threadIdx.x, lane = tid & 63, wave = tid >> 6;
  constexpr int J_SCAN = 512, J_NORM = 4096, J_MEMK = 128;
  for (int job = bid; job < J_SCAN + J_NORM + J_MEMK; job += nb) {
    if (job < J_SCAN) {
      int idx = job * 256 + tid;
      int d = idx & 127, e = (idx >> 7) & 127, bh = idx >> 14;
      bf16_t* L = (bf16_t*)(ws + OFF_L) + (size_t)bh * 128 * 16384 + e * 128 + d;
      const float* dec = (const float*)(ws + OFF_DEC) + (size_t)bh * 128 * 128 + d;
      float S = 0.f;
      float tA[16], dA[16], tB[16], dB[16];
#pragma unroll
      for (int i = 0; i < 16; ++i) { tA[i] = bf2f(L[(size_t)i * 16384]); dA[i] = dec[i * 128]; }
#pragma unroll 1
      for (int c0 = 0; c0 < 128; c0 += 32) {
#pragma unroll
        for (int i = 0; i < 16; ++i) { tB[i] = bf2f(L[(size_t)(c0 + 16 + i) * 16384]); dB[i] = dec[(c0 + 16 + i) * 128]; }
#pragma unroll
        for (int i = 0; i < 16; ++i) { L[(size_t)(c0 + i) * 16384] = f2bf(S); S = dA[i] * S + tA[i]; }
        if (c0 + 32 < 128) {
#pragma unroll
          for (int i = 0; i < 16; ++i) { tA[i] = bf2f(L[(size_t)(c0 + 32 + i) * 16384]); dA[i] = dec[(c0 + 32 + i) * 128]; }
        }
#pragma unroll
        for (int i = 0; i < 16; ++i) { L[(size_t)(c0 + 16 + i) * 16384] = f2bf(S); S = dB[i] * S + tB[i]; }
      }
      continue;
    }
    int j = job - J_SCAN;
    if (j < J_NORM) {
      const int t = j * 4 + wave;
      const float cs = ((const float*)(ws + OFF_COS))[t * 32 + (lane & 31)];
      const float sn = ((const float*)(ws + OFF_SIN))[t * 32 + (lane & 31)];
      const float sgn = lane < 32 ? -1.f : 1.f;
      const float qscale = 0.07216878364870322f * LOG2E;
      bf16_t* Q = (bf16_t*)(ws + OFF_Q) + (size_t)t * 768;
      bf16_t* K = (bf16_t*)(ws + OFF_K) + ((size_t)((t >> 13) * 4) * SEQ + (t & (SEQ - 1))) * 192;
      const float kr = bf2f(((const bf16_t*)(ws + OFF_PROJA))[(size_t)t * 704 + 640 + lane]);
      const float gq0 = P.mla_q_norm[lane], gq1 = P.mla_q_norm[64 + lane], gq2 = P.mla_q_norm[128 + lane];
      const float gk0 = P.mla_k_norm[lane], gk1 = P.mla_k_norm[64 + lane], gk2 = P.mla_k_norm[128 + lane];
      bf16_t* M = (bf16_t*)(ws + OFF_PROJM) + (size_t)t * LD_PM;
      const float gm0 = P.mem_q_norm[lane], gm1 = P.mem_q_norm[64 + lane];
      float qv[4][3], kv[4][2], mv[4][2];
#pragma unroll
      for (int hh = 0; hh < 4; ++hh) {
        qv[hh][0] = bf2f(Q[hh * 192 + lane]); qv[hh][1] = bf2f(Q[hh * 192 + 64 + lane]); qv[hh][2] = bf2f(Q[hh * 192 + 128 + lane]);
        kv[hh][0] = bf2f(K[(size_t)hh * SEQ * 192 + lane]); kv[hh][1] = bf2f(K[(size_t)hh * SEQ * 192 + 64 + lane]);
        mv[hh][0] = bf2f(M[hh * 128 + lane]); mv[hh][1] = bf2f(M[hh * 128 + 64 + lane]);
      }
      float sq[4], sk[4], sm[4];
#pragma unroll
      for (int hh = 0; hh < 4; ++hh) {
        sq[hh] = qv[hh][0] * qv[hh][0] + qv[hh][1] * qv[hh][1] + qv[hh][2] * qv[hh][2];
        sk[hh] = kv[hh][0] * kv[hh][0] + kv[hh][1] * kv[hh][1] + kr * kr;
        sm[hh] = mv[hh][0] * mv[hh][0] + mv[hh][1] * mv[hh][1];
      }
#pragma unroll
      for (int o = 32; o >= 1; o >>= 1) {
#pragma unroll
        for (int hh = 0; hh < 4; ++hh) {
          sq[hh] += __shfl_xor(sq[hh], o, 64); sk[hh] += __shfl_xor(sk[hh], o, 64); sm[hh] += __shfl_xor(sm[hh], o, 64);
        }
      }
#pragma unroll
      for (int hh = 0; hh < 4; ++hh) {
        {
          float rstd = rsqrtf(sq[hh] * (1.f / 192.f) + EPS);
          float n0 = qv[hh][0] * rstd * gq0, n1 = qv[hh][1] * rstd * gq1, n2 = qv[hh][2] * rstd * gq2;
          float pr = __shfl_xor(n2, 32, 64);
          float ro = n2 * cs + sgn * pr * sn;
          Q[hh * 192 + lane] = f2bf(n0 * qscale); Q[hh * 192 + 64 + lane] = f2bf(n1 * qscale); Q[hh * 192 + 128 + lane] = f2bf(ro * qscale);
        }
        {
          float rstd = rsqrtf(sk[hh] * (1.f / 192.f) + EPS);
          float n0 = kv[hh][0] * rstd * gk0, n1 = kv[hh][1] * rstd * gk1, n2 = kr * rstd * gk2;
          float pr = __shfl_xor(n2, 32, 64);
          float ro = n2 * cs + sgn * pr * sn;
          K[(size_t)hh * SEQ * 192 + lane] = f2bf(n0); K[(size_t)hh * SEQ * 192 + 64 + lane] = f2bf(n1); K[(size_t)hh * SEQ * 192 + 128 + lane] = f2bf(ro);
        }
        {
          float rstd = rsqrtf(sm[hh] * (1.f / 128.f) + EPS) * (0.08838834764831845f * LOG2E);
          M[hh * 128 + lane] = f2bf(mv[hh][0] * rstd * gm0); M[hh * 128 + 64 + lane] = f2bf(mv[hh][1] * rstd * gm1);
        }
      }
      continue;
    }
    j -= J_NORM;
    {
      const int m = j * 4 + wave;
      const int b = m >> 8, key = m & 255;
      const float* src = (const float*)(ws + OFF_MEMKV) + (size_t)m * 1024;
      for (int hh = 0; hh < 4; ++hh) {
        float v0 = src[hh * 128 + lane], v1 = src[hh * 128 + 64 + lane];
        float ss = wave_sum(v0 * v0 + v1 * v1);
        float rstd = rsqrtf(ss * (1.f / 128.f) + EPS);
        bf16_t* km = (bf16_t*)(ws + OFF_KMEM) + ((size_t)((b * 4 + hh) * 256 + key)) * 128;
        km[lane] = f2bf(v0 * rstd * P.mem_k_norm[lane]); km[64 + lane] = f2bf(v1 * rstd * P.mem_k_norm[64 + lane]);
        bf16_t* vm = (bf16_t*)(ws + OFF_VMEMT) + ((size_t)(b * 4 + hh) * 128) * 256 + key;
        vm[(size_t)lane * 256] = f2bf(src[512 + hh * 128 + lane]);
        vm[(size_t)(64 + lane) * 256] = f2bf(src[512 + hh * 128 + 64 + lane]);
      }
    }
  }
}

constexpr int AV_ROWB = 136;
template <int DQK, bool CAUSAL>
__device__ __forceinline__ void attn_item(const bf16_t* Q, int ldq, const bf16_t* K, int ldk, const bf16_t* Vt, int ldv, int vts, int q0, int nkeys,
                          bf16_t* Y, int ldy, float* ssout, char* smem) {
  constexpr int KROWB = (DQK + 8) * 2;
  constexpr int KCH = DQK / 8;
  constexpr int NKL = (64 * KCH) / 256;
  constexpr int NKS = DQK / 16;
  int tid = threadIdx.x;
  asm volatile("" : "+v"(tid));
  const int lane = tid & 63, wave = tid >> 6, r = lane & 31, h = lane >> 5;
  const int rg = wave & 1, kh = wave >> 1;
  char* sK = smem;
  char* sV = smem + 64 * KROWB;
  const int qrow = q0 + rg * 32 + r;

  char* sQ = smem + 64 * KROWB + 128 * AV_ROWB;
  f32x16 oacc[4];
  for (int i = 0; i < 4; ++i) oacc[i] = zero16();
  float m_run = -INFINITY, l_run = 0.f;
  const int ntiles = CAUSAL ? (q0 + 64) / 64 : nkeys / 64;

  uint4 rk0, rk1, rk2, rk3, rk4, rk5, rv0, rv1, rv2, rv3;
  rk4 = make_uint4(0, 0, 0, 0); rk5 = rk4;
#define AT_KOFF(i) ((unsigned)(((tid + 256 * (i)) / KCH) * ldk + ((tid + 256 * (i)) % KCH) * 8) * 2u)
#define AT_VOFF(i) ((unsigned)(((tid + 256 * (i)) >> 3) * ldv + ((tid + 256 * (i)) & 7) * 8) * 2u)
#define AT_KLDS(i) (sK + ((tid + 256 * (i)) / KCH) * KROWB + ((tid + 256 * (i)) % KCH) * 16)
#define AT_VLDS(i) (sV + ((tid + 256 * (i)) >> 3) * AV_ROWB + ((tid + 256 * (i)) & 7) * 16)
#define AT_LOADG(kt_)                                                                   \
  {                                                                                     \
    const char* kb_ = (const char*)(K + (size_t)(kt_) * 64 * ldk);                      \
    const char* vb_ = (const char*)(Vt + (size_t)(kt_) * vts);                          \
    rk0 = *(const uint4*)(kb_ + AT_KOFF(0)); rk1 = *(const uint4*)(kb_ + AT_KOFF(1));   \
    rk2 = *(const uint4*)(kb_ + AT_KOFF(2)); rk3 = *(const uint4*)(kb_ + AT_KOFF(3));   \
    if (NKL > 4) { rk4 = *(const uint4*)(kb_ + AT_KOFF(4)); rk5 = *(const uint4*)(kb_ + AT_KOFF(5)); } \
    rv0 = *(const uint4*)(vb_ + AT_VOFF(0)); rv1 = *(const uint4*)(vb_ + AT_VOFF(1));   \
    rv2 = *(const uint4*)(vb_ + AT_VOFF(2)); rv3 = *(const uint4*)(vb_ + AT_VOFF(3));   \
  }
#define AT_VST(i, v)                                                    \
  {                                                                     \
    *(uint2*)(AT_VLDS(i)) = make_uint2(v.x, v.y);                       \
    *(uint2*)(AT_VLDS(i) + 8) = make_uint2(v.z, v.w);                   \
  }
#define AT_STOREL()                                                                     \
  {                                                                                     \
    *(uint4*)(AT_KLDS(0)) = rk0; *(uint4*)(AT_KLDS(1)) = rk1;                           \
    *(uint4*)(AT_KLDS(2)) = rk2; *(uint4*)(AT_KLDS(3)) = rk3;                           \
    if (NKL > 4) { *(uint4*)(AT_KLDS(4)) = rk4; *(uint4*)(AT_KLDS(5)) = rk5; }          \
    AT_VST(0, rv0) AT_VST(1, rv1) AT_VST(2, rv2) AT_VST(3, rv3)                         \
  }

  AT_LOADG(0);
  for (int c = tid; c < 64 * KCH; c += 256) {
    const int row = c / KCH, kc = c - row * KCH;
    *(uint4*)(sQ + row * KROWB + kc * 16) = *(const uint4*)(Q + (size_t)(q0 + row) * ldq + kc * 8);
  }

  AT_STOREL();
  __syncthreads();
  constexpr int NQR = NKS;
  bf16x8 qh[NQR];
#pragma unroll
  for (int ks = 0; ks < NQR; ++ks) qh[ks] = *(const bf16x8*)(sQ + (rg * 32 + r) * KROWB + ks * 32 + h * 16);
  for (int kt = 0; kt < ntiles; ++kt) {
    if (kt + 1 < ntiles) AT_LOADG(kt + 1);
    __builtin_amdgcn_sched_barrier(0);
    const int k0 = kt * 64 + kh * 32;
    f32x16 sc = zero16();
    __builtin_amdgcn_s_setprio(1);
#pragma unroll
    for (int ks = 0; ks < NKS; ++ks) {
      bf16x8 a0 = *(const bf16x8*)(sK + (kh * 32 + r) * KROWB + ks * 32 + h * 16);
      bf16x8 bq;
      if (ks < NQR) bq = qh[ks < NQR ? ks : 0]; else bq = *(const bf16x8*)(sQ + (rg * 32 + r) * KROWB + ks * 32 + h * 16);
      sc = MFMA(a0, bq, sc);

    }
    if (CAUSAL) {
      if (k0 + 31 > q0 + rg * 32) {
#pragma unroll
        for (int q = 0; q < 16; ++q) {
          int key = k0 + crow(q, h);
          if (key > qrow) sc[q] = -INFINITY;
        }
      }
    }
    float mx = sc[0];
#pragma unroll
    for (int q = 1; q < 16; ++q) mx = fmaxf(mx, sc[q]);
    {
      auto sw = __builtin_amdgcn_permlane32_swap(__float_as_uint(mx), __float_as_uint(mx), false, false);
      mx = fmaxf(__uint_as_float(sw[0]), __uint_as_float(sw[1]));
    }
    if (__builtin_amdgcn_ballot_w64(mx > m_run + 8.f) != 0ull) {
      const float m_new = fmaxf(m_run, mx);
      const float m_safe = (m_new == -INFINITY) ? 0.f : m_new;
      const float alpha = __builtin_amdgcn_exp2f(m_run - m_safe);
      m_run = m_new;
      l_run *= alpha;
#pragma unroll
      for (int dt = 0; dt < 4; ++dt)
#pragma unroll
        for (int q = 0; q < 16; ++q) oacc[dt][q] *= alpha;
    }
    const float m_ref = (m_run == -INFINITY) ? 0.f : m_run;
    float ls = 0.f;
#pragma unroll
    for (int q = 0; q < 16; ++q) { sc[q] = __builtin_amdgcn_exp2f(sc[q] - m_ref); ls += sc[q]; }
    l_run += ls;
#pragma unroll
    for (int s2 = 0; s2 < 2; ++s2) {
      bf16x8 pb = pack8(sc, s2);
#pragma unroll
      for (int dt = 0; dt < 4; ++dt) {
        const char* vp = sV + (dt * 32 + r) * AV_ROWB + (32 * kh + 16 * s2 + 4 * h) * 2;
        uint2 lo = *(const uint2*)vp;
        uint2 hi = *(const uint2*)(vp + 16);
        uint4 av = make_uint4(lo.x, lo.y, hi.x, hi.y);
        oacc[dt] = MFMA(__builtin_bit_cast(bf16x8, av), pb, oacc[dt]);
      }
      __builtin_amdgcn_sched_barrier(0);
    }
    __builtin_amdgcn_s_setprio(0);
    __syncthreads();
    if (kt + 1 < ntiles) { AT_STOREL(); }
    __syncthreads();
  }
  float* mO = (float*)smem + rg * (66 * 64);
  if (kh == 1) {
#pragma unroll
    for (int dt = 0; dt < 4; ++dt)
#pragma unroll
      for (int q = 0; q < 16; ++q) mO[(dt * 16 + q) * 64 + lane] = oacc[dt][q];
    mO[64 * 64 + lane] = m_run;
    mO[65 * 64 + lane] = l_run;
  }
  __syncthreads();
  if (kh == 0) {
    const float m_b = mO[64 * 64 + lane], l_b = mO[65 * 64 + lane];
    const float m = fmaxf(m_run, m_b);
    const float fa = __builtin_amdgcn_exp2f(m_run - m), fb = __builtin_amdgcn_exp2f(m_b - m);
    float lsum = l_run * fa + l_b * fb;
    lsum += __shfl_xor(lsum, 32, 64);
    const float inv = 1.f / lsum;
    const float ca = fa * inv, cb = fb * inv;
    float ssq = 0.f;
#pragma unroll
    for (int dt = 0; dt < 4; ++dt)
#pragma unroll
      for (int g4 = 0; g4 < 4; ++g4) {
        float o0 = oacc[dt][4 * g4] * ca + mO[(dt * 16 + 4 * g4) * 64 + lane] * cb;
        float o1 = oacc[dt][4 * g4 + 1] * ca + mO[(dt * 16 + 4 * g4 + 1) * 64 + lane] * cb;
        float o2 = oacc[dt][4 * g4 + 2] * ca + mO[(dt * 16 + 4 * g4 + 2) * 64 + lane] * cb;
        float o3 = oacc[dt][4 * g4 + 3] * ca + mO[(dt * 16 + 4 * g4 + 3) * 64 + lane] * cb;
        ssq += o0 * o0 + o1 * o1 + o2 * o2 + o3 * o3;
        uint2 u; u.x = pack2(o0, o1); u.y = pack2(o2, o3);
        *(uint2*)(Y + (size_t)qrow * ldy + dt * 32 + 8 * g4 + 4 * h) = u;
      }
    ssq += __shfl_xor(ssq, 32, 64);
    if (h == 0) atomicAdd(ssout + qrow, ssq);
  }
  __syncthreads();
}

template <int DQK, bool CAUSAL>
__device__ __forceinline__ void attn_item128(const bf16_t* Q, int ldq, const bf16_t* K, int ldk, const bf16_t* Vt, int ldv, int vts,
                                          int q0, int kt0, int kt1, bf16_t* Y, int ldy, float* ssout, char* smem) {
  constexpr int KROWB = (DQK + 8) * 2;
  constexpr int KCH = DQK / 8;
  constexpr int NKL = (64 * KCH) / 256;
  constexpr int NKS = DQK / 16;
  int tid = threadIdx.x;
  asm volatile("" : "+v"(tid));
  const int lane = tid & 63, wave = tid >> 6, r = lane & 31, h = lane >> 5;
  char* sK = smem;
  char* sV = smem + 64 * KROWB;
  const int qrow = q0 + wave * 32 + r;

  bf16x8 qf[NKS];
#pragma unroll
  for (int ks = 0; ks < NKS; ++ks) qf[ks] = *(const bf16x8*)(Q + (size_t)qrow * ldq + ks * 16 + h * 8);

  f32x16 oacc[4];
  for (int i = 0; i < 4; ++i) oacc[i] = zero16();
  float m_run = -INFINITY, l_run = 0.f;

  uint4 rk0, rk1, rk2, rk3, rk4, rk5, rv0, rv1, rv2, rv3;
  rk4 = make_uint4(0, 0, 0, 0); rk5 = rk4;
#define BAT_KOFF(i) ((unsigned)(((tid + 256 * (i)) / KCH) * ldk + ((tid + 256 * (i)) % KCH) * 8) * 2u)
#define BAT_VOFF(i) ((unsigned)(((tid + 256 * (i)) >> 3) * ldv + ((tid + 256 * (i)) & 7) * 8) * 2u)
#define BAT_KLDS(i) (sK + ((tid + 256 * (i)) / KCH) * KROWB + ((tid + 256 * (i)) % KCH) * 16)
#define BAT_VLDS(i) (sV + ((tid + 256 * (i)) >> 3) * AV_ROWB + ((tid + 256 * (i)) & 7) * 16)
#define BAT_LOADG(kt_)                                                                   \
  {                                                                                     \
    const char* kb_ = (const char*)(K + (size_t)(kt_) * 64 * ldk);                      \
    const char* vb_ = (const char*)(Vt + (size_t)(kt_) * vts);                          \
    rk0 = *(const uint4*)(kb_ + BAT_KOFF(0)); rk1 = *(const uint4*)(kb_ + BAT_KOFF(1));   \
    rk2 = *(const uint4*)(kb_ + BAT_KOFF(2)); rk3 = *(const uint4*)(kb_ + BAT_KOFF(3));   \
    if (NKL > 4) { rk4 = *(const uint4*)(kb_ + BAT_KOFF(4)); rk5 = *(const uint4*)(kb_ + BAT_KOFF(5)); } \
    rv0 = *(const uint4*)(vb_ + BAT_VOFF(0)); rv1 = *(const uint4*)(vb_ + BAT_VOFF(1));   \
    rv2 = *(const uint4*)(vb_ + BAT_VOFF(2)); rv3 = *(const uint4*)(vb_ + BAT_VOFF(3));   \
  }
#define BAT_VST(i, v)                                                    \
  {                                                                     \
    *(uint2*)(BAT_VLDS(i)) = make_uint2(v.x, v.y);                       \
    *(uint2*)(BAT_VLDS(i) + 8) = make_uint2(v.z, v.w);                   \
  }
#define BAT_STOREL()                                                                     \
  {                                                                                     \
    *(uint4*)(BAT_KLDS(0)) = rk0; *(uint4*)(BAT_KLDS(1)) = rk1;                           \
    *(uint4*)(BAT_KLDS(2)) = rk2; *(uint4*)(BAT_KLDS(3)) = rk3;                           \
    if (NKL > 4) { *(uint4*)(BAT_KLDS(4)) = rk4; *(uint4*)(BAT_KLDS(5)) = rk5; }          \
    BAT_VST(0, rv0) BAT_VST(1, rv1) BAT_VST(2, rv2) BAT_VST(3, rv3)                         \
  }

  BAT_LOADG(kt0);
  BAT_STOREL();
  __syncthreads();
  for (int kt = kt0; kt < kt1; ++kt) {
    if (kt + 1 < kt1) BAT_LOADG(kt + 1);
    __builtin_amdgcn_sched_barrier(0);
    __builtin_amdgcn_s_setprio(1);
#pragma unroll
    for (int kh = 0; kh < 2; ++kh) {
      const int k0 = kt * 64 + kh * 32;
      f32x16 sc = zero16();
#pragma unroll
      for (int ks = 0; ks < NKS; ++ks) {
        bf16x8 a0 = *(const bf16x8*)(sK + (kh * 32 + r) * KROWB + ks * 32 + h * 16);
        sc = MFMA(a0, qf[ks], sc);
      }
      if (CAUSAL) {
        if (k0 + 31 > q0 + wave * 32) {
#pragma unroll
          for (int q = 0; q < 16; ++q) {
            int key = k0 + crow(q, h);
            if (key > qrow) sc[q] = -INFINITY;
          }
        }
      }
      float mx = sc[0];
#pragma unroll
      for (int q = 1; q < 16; ++q) mx = fmaxf(mx, sc[q]);
      {
        auto sw = __builtin_amdgcn_permlane32_swap(__float_as_uint(mx), __float_as_uint(mx), false, false);
        mx = fmaxf(__uint_as_float(sw[0]), __uint_as_float(sw[1]));
      }
      if (__builtin_amdgcn_ballot_w64(mx > m_run + 8.f) != 0ull) {
        const float m_new = fmaxf(m_run, mx);
        const float m_safe = (m_new == -INFINITY) ? 0.f : m_new;
        const float alpha = __builtin_amdgcn_exp2f(m_run - m_safe);
        m_run = m_new;
        l_run *= alpha;
#pragma unroll
        for (int dt = 0; dt < 4; ++dt)
#pragma unroll
          for (int q = 0; q < 16; ++q) oacc[dt][q] *= alpha;
      }
      const float m_ref = (m_run == -INFINITY) ? 0.f : m_run;
      float ls = 0.f;
#pragma unroll
      for (int q = 0; q < 16; ++q) { sc[q] = __builtin_amdgcn_exp2f(sc[q] - m_ref); ls += sc[q]; }
      l_run += ls;
#pragma unroll
      for (int s2 = 0; s2 < 2; ++s2) {
        bf16x8 pb = pack8(sc, s2);
#pragma unroll
        for (int dt = 0; dt < 4; ++dt) {
          const char* vp = sV + (dt * 32 + r) * AV_ROWB + (32 * kh + 16 * s2 + 4 * h) * 2;
          uint2 lo = *(const uint2*)vp;
          uint2 hi = *(const uint2*)(vp + 16);
          uint4 av = make_uint4(lo.x, lo.y, hi.x, hi.y);
          oacc[dt] = MFMA(__builtin_bit_cast(bf16x8, av), pb, oacc[dt]);
        }
      }
      __builtin_amdgcn_sched_barrier(0);
    }
    __builtin_amdgcn_s_setprio(0);
    __syncthreads();
    if (kt + 1 < kt1) { BAT_STOREL(); }
    __syncthreads();
  }
  const float l = l_run + __shfl_xor(l_run, 32, 64);
  const float ca = 1.f / l;
  float ssq = 0.f;
#pragma unroll
  for (int dt = 0; dt < 4; ++dt)
#pragma unroll
    for (int g4 = 0; g4 < 4; ++g4) {
      float o0 = oacc[dt][4 * g4] * ca, o1 = oacc[dt][4 * g4 + 1] * ca, o2 = oacc[dt][4 * g4 + 2] * ca, o3 = oacc[dt][4 * g4 + 3] * ca;
      ssq += o0 * o0 + o1 * o1 + o2 * o2 + o3 * o3;
      uint2 u; u.x = pack2(o0, o1); u.y = pack2(o2, o3);
      *(uint2*)(Y + (size_t)qrow * ldy + dt * 32 + 8 * g4 + 4 * h) = u;
    }
  ssq += __shfl_xor(ssq, 32, 64);
  if (h == 0) atomicAdd(ssout + qrow, ssq);
}

__device__ void hg_output(const Params& P, int item, char* smem) {
  char* ws = P.ws;
  const int tid = threadIdx.x, lane = tid & 63, wave = tid >> 6, r = lane & 31, h = lane >> 5;
  const int bh = item >> 7, c = item & 127, b = bh >> 2, hh = bh & 3;
  const int t0 = b * SEQ + c * 64;
  char* sq = smem;
  char* sk = smem + 64 * QK_ROWB;
  char* svT = smem + 128 * QK_ROWB;
  float* ssum = (float*)(smem + 128 * QK_ROWB + 128 * VT_ROWB);
  {
    const bf16_t* src = (const bf16_t*)(ws + OFF_PROJH) + (size_t)t0 * LD_PH + hh * 128;
    hg_tile_to_lds(src, sq);
    hg_tile_to_lds(src + 512, sk);
    hg_build_vT(src + 1024, svT);
  }
  __syncthreads();
  if (tid < 128) {
    const int d = tid;
    const float lb = ((const float*)(ws + OFF_LB))[hh * 128 + d];
    float bc = 0.f;
    for (int t8 = 0; t8 < 64; t8 += 8) {
      float qv[8], fv[8];
#pragma unroll
      for (int i = 0; i < 8; ++i) {
        qv[i] = bf2f(*(const bf16_t*)(sq + (t8 + i) * QK_ROWB + d * 2));
        fv[i] = bf2f(*(const bf16_t*)(sk + (t8 + i) * QK_ROWB + d * 2));
      }
#pragma unroll
      for (int i = 0; i < 8; ++i) {
        float f = lb + (1.f - lb) * sigmoidf_(fv[i]);
        bc += __builtin_amdgcn_logf(f);
        float qs = qv[i] * sigmoidf_(qv[i]) * 0.08838834764831845f * __builtin_amdgcn_exp2f(bc);
        float kx = (1.f - f) * __builtin_amdgcn_exp2f(-bc);
        *(bf16_t*)(sq + (t8 + i) * QK_ROWB + d * 2) = f2bf(qs);
        *(bf16_t*)(sk + (t8 + i) * QK_ROWB + d * 2) = f2bf(kx);
      }
    }
  }
  __syncthreads();
  const int tt = wave & 1, eh = wave >> 1;
  f32x16 x0 = zero16(), x1 = zero16();
#pragma unroll
  for (int ks = 0; ks < 8; ++ks) {
    bf16x8 bq = *(const bf16x8*)(sq + (tt * 32 + r) * QK_ROWB + ks * 32 + h * 16);
    bf16x8 a0 = *(const bf16x8*)(sk + r * QK_ROWB + ks * 32 + h * 16);
    x0 = MFMA(a0, bq, x0);
    if (tt == 1) {
      bf16x8 a1 = *(const bf16x8*)(sk + (32 + r) * QK_ROWB + ks * 32 + h * 16);
      x1 = MFMA(a1, bq, x1);
    }
  }
  if (tt == 0) {
#pragma unroll
    for (int q = 0; q < 16; ++q) if (crow(q, h) > r) x0[q] = 0.f;
  } else {
#pragma unroll
    for (int q = 0; q < 16; ++q) if (crow(q, h) > r) x1[q] = 0.f;
  }
  f32x16 o[2];
  o[0] = zero16(); o[1] = zero16();
  const int nst = (tt == 0) ? 2 : 4;
#pragma unroll
  for (int s = 0; s < 4; ++s) {
    if (s < nst) {
      bf16x8 pb = (s < 2) ? pack8(x0, s & 1) : pack8(x1, s & 1);
#pragma unroll
      for (int et = 0; et < 2; ++et) {
        const char* vp = svT + ((eh * 2 + et) * 32 + r) * VT_ROWB + (16 * s + 4 * h) * 2;
        uint2 lo = *(const uint2*)vp;
        uint2 hi = *(const uint2*)(vp + 16);
        uint4 av = make_uint4(lo.x, lo.y, hi.x, hi.y);
        o[et] = MFMA(__builtin_bit_cast(bf16x8, av), pb, o[et]);
      }
    }
  }
  const bf16_t* St = (const bf16_t*)(ws + OFF_L) + (size_t)(bh * 128 + c) * 16384;
#pragma unroll
  for (int ks = 0; ks < 8; ++ks) {
    bf16x8 bq = *(const bf16x8*)(sq + (tt * 32 + r) * QK_ROWB + ks * 32 + h * 16);
#pragma unroll
    for (int et = 0; et < 2; ++et) {
      bf16x8 a = *(const bf16x8*)(St + ((eh * 2 + et) * 32 + r) * 128 + ks * 16 + h * 8);
      o[et] = MFMA(a, bq, o[et]);
    }
  }
  float ssq = 0.f;
#pragma unroll
  for (int et = 0; et < 2; ++et)
#pragma unroll
    for (int q = 0; q < 16; ++q) ssq += o[et][q] * o[et][q];
  ssq += __shfl_xor(ssq, 32, 64);
  if (h == 0) ssum[eh * 64 + tt * 32 + r] = ssq;
  __syncthreads();
  const float tot = ssum[tt * 32 + r] + ssum[64 + tt * 32 + r];
  const float rstd = rsqrtf(tot * (1.f / 128.f) + EPS);
  bf16_t* gp = (bf16_t*)(ws + OFF_PROJH) + (size_t)(t0 + tt * 32 + r) * LD_PH + 1536 + hh * 128;
#pragma unroll
  for (int et = 0; et < 2; ++et)
#pragma unroll
    for (int g4 = 0; g4 < 4; ++g4) {
      const int e = (eh * 2 + et) * 32 + 8 * g4 + 4 * h;
      uint2 gu = *(const uint2*)(gp + e);
      float4 gn = *(const float4*)(P.hg_out_norm + hh * 128 + e);
      float g0 = lo2f(gu.x), g1 = hi2f(gu.x), g2 = lo2f(gu.y), g3 = hi2f(gu.y);
      float y0 = o[et][4 * g4] * rstd * gn.x * g0 * sigmoidf_(g0);
      float y1 = o[et][4 * g4 + 1] * rstd * gn.y * g1 * sigmoidf_(g1);
      float y2 = o[et][4 * g4 + 2] * rstd * gn.z * g2 * sigmoidf_(g2);
      float y3 = o[et][4 * g4 + 3] * rstd * gn.w * g3 * sigmoidf_(g3);
      uint2 u; u.x = pack2(y0, y1); u.y = pack2(y2, y3);
      *(uint2*)(gp + e) = u;
    }
  __syncthreads();
}

DI int next_item(unsigned* cnt, int* s_item) {
  if (threadIdx.x == 0) *s_item = (int)atomicAdd(cnt, 1u);
  __syncthreads();
  const int item = *s_item;
  __syncthreads();
  return item;
}
__device__ void phase4(const Params& P, char* smem) {
  char* ws = P.ws;
  __shared__ int s_item;
  unsigned* cnt = (unsigned*)(ws + OFF_CNT);
  constexpr int N_MLA = 1024, N_MEM = 1024, N_H3 = 1024;
  while (true) {
    const int item = next_item(cnt, &s_item);
    if (item >= N_MLA) break;
    const int qt = 127 - (item >> 3), bh = item & 7, b = bh >> 2, hh = bh & 3;
    attn_item<192, true>((const bf16_t*)(ws + OFF_Q) + (size_t)b * SEQ * 768 + hh * 192, 768,
                         (const bf16_t*)(ws + OFF_K) + (size_t)bh * SEQ * 192, 192,
                         (const bf16_t*)(ws + OFF_VT) + (size_t)bh * 128 * 8192, 64, 8192, qt * 64, 0,
                         (bf16_t*)(ws + OFF_YMLA) + (size_t)b * SEQ * LD_YMLA + hh * 128, LD_YMLA,
                         (float*)(ws + OFF_SS) + b * SEQ, smem);
  }
  while (true) {
    const int u = next_item(cnt + 1, &s_item);
    if (u >= N_MEM / 2) break;
    const int bh = u & 7, qt = u >> 3, b = bh >> 2, hh = bh & 3;
    bf16_t* qp = (bf16_t*)(ws + OFF_PROJM) + (size_t)b * SEQ * LD_PM + hh * 128;
    attn_item128<128, false>(qp, LD_PM, (const bf16_t*)(ws + OFF_KMEM) + (size_t)bh * 256 * 128, 128,
                             (const bf16_t*)(ws + OFF_VMEMT) + (size_t)bh * 128 * 256, 256, 64, qt * 128, 0, 4, qp, LD_PM,
                             (float*)(ws + OFF_SS) + T_TOK + b * SEQ, smem);
  }
  while (true) {
    const int u = next_item(cnt + 2, &s_item);
    if (u >= N_H3) break;
    hg_output(P, u, smem);
  }
}

__device__ void phase5(const Params& P, int bid, int nb, char* smem) {
  char* ws = P.ws;
  GArgs g;
  g.A0 = (const bf16_t*)(ws + OFF_YMLA); g.lda0 = LD_YMLA; g.kb0 = 0;
  g.A1 = (const bf16_t*)(ws + OFF_PROJM); g.lda1 = LD_PM; g.kb1 = 1024;
  g.A2 = (const bf16_t*)(ws + OFF_PROJH) + 1536; g.lda2 = LD_PH; g.kb2 = 512;
  g.segIters = 8; g.nIter = 24; g.Ktot = 1536; g.Bt = (const bf16_t*)(ws + OFF_WT_OUT); g.ldb = LD_WOUT;
  for (int t = bid; t < 64 * 8; t += nb) { int mt, nt; tile_mn(t, 8, mt, nt); gemm_tile<EPI_OUT>(P, g, mt * 256, nt * 128, smem); }
}
__device__ void phase6(const Params& P, int bid, int nb, char* smem) {
  char* ws = P.ws;
  GArgs g = garg1((const bf16_t*)(ws + OFF_X1B), LD_XB, 1024, (const bf16_t*)(ws + OFF_WT_GU), LD_WGU);
  for (int t = bid; t < 64 * 44; t += nb) { int mt, nt; tile_mn(t, 44, mt, nt); gemm_tile<EPI_GU>(P, g, mt * 256, nt * 128, smem); }
}
__device__ void phase7(const Params& P, int bid, int nb, char* smem) {
  char* ws = P.ws;
  GArgs g = garg1((const bf16_t*)(ws + OFF_ACT), LD_ACT, 2816, (const bf16_t*)(ws + OFF_WT_DN), LD_WDN);
  for (int t = bid; t < 64 * 8; t += nb) { int mt, nt; tile_mn(t, 8, mt, nt); gemm_tile<EPI_DOWN>(P, g, mt * 256, nt * 128, smem); }
}


#define XB_TMO      128
#define XB_XCNT(j)  (256  + 64 * (j))
#define XB_XSUB(j)  (1280 + 64 * (j))
#define XB_XGEN(j)  (2304 + 64 * (j))
#define XB_TOP      3328
#define XB_TOPGEN   3392
#define XCD_BAR_WORDS 3456
#define XB_SPIN_CAP (1u << 18)
#define LAS __attribute__((address_space(3)))
DI unsigned xb_ld(unsigned* p) { return __hip_atomic_load(p, __ATOMIC_RELAXED, __HIP_MEMORY_SCOPE_AGENT); }
DI unsigned xb_add(unsigned* p, unsigned v) { return __hip_atomic_fetch_add(p, v, __ATOMIC_RELAXED, __HIP_MEMORY_SCOPE_AGENT); }
DI unsigned xb_xcc_id() { return (unsigned)__builtin_amdgcn_s_getreg((3 << 11) | 20) & 0xFu; }
#define XB_SPIN(cond, bar) do { unsigned _sp = 0; while (cond) { __builtin_amdgcn_s_sleep(1); \
    if ((++_sp & 255u) == 0u) { if (xb_ld(&(bar)[XB_TMO])) break; if (_sp > XB_SPIN_CAP) { atomicAdd(&(bar)[XB_TMO], 1u); break; } } } } while (0)
struct XcdBarrier { unsigned* bar; unsigned x; volatile LAS unsigned* st; };
DI XcdBarrier xcd_barrier_post(unsigned* bar, volatile LAS unsigned* st) {
  XcdBarrier b; b.bar = bar; b.x = xb_xcc_id(); b.st = st;
  if (threadIdx.x == 0) (void)xb_add(&bar[XB_XCNT(b.x)], 1u);
  return b;
}
DI void xcd_barrier_complete(unsigned* bar, unsigned x, unsigned& nloc, unsigned& nx) {
  const unsigned G = gridDim.x * gridDim.y * gridDim.z;
  unsigned sum, cnt, mine, sp = 0u;
  for (;;) {
    sum = 0u; cnt = 0u; mine = 0u;
#pragma unroll
    for (unsigned j = 0; j < 16; ++j) { const unsigned c = xb_ld(&bar[XB_XCNT(j)]); sum += c; cnt += (c > 0u) ? 1u : 0u; mine = (j == x) ? c : mine; }
    if (sum == G) break;
    __builtin_amdgcn_s_sleep(1);
    if ((++sp & 255u) == 0u) { if (xb_ld(&bar[XB_TMO])) break; if (sp > XB_SPIN_CAP) { atomicAdd(&bar[XB_TMO], 1u); break; } }
  }
  nloc = mine > 0u ? mine : 1u; nx = cnt > 0u ? cnt : 1u;
}
DI void xcd_barrier(const XcdBarrier& b) {
  asm volatile("s_waitcnt vmcnt(0)" ::: "memory");
  __syncthreads();
  if (threadIdx.x == 0) {
    unsigned* bar = b.bar;
    __builtin_amdgcn_s_waitcnt(0);
    unsigned nloc = b.st[0], nx = b.st[1];
    if (nloc == 0u) { xcd_barrier_complete(bar, b.x, nloc, nx); b.st[0] = nloc; b.st[1] = nx; }
    const unsigned old = xb_add(&bar[XB_XSUB(b.x)], 1u);
    const unsigned gen = old / nloc;
    if (old + 1u == (gen + 1u) * nloc) {
      __builtin_amdgcn_fence(__ATOMIC_RELEASE, "agent");
      asm volatile("s_waitcnt vmcnt(0)" ::: "memory");
      const unsigned og = xb_add(&bar[XB_TOP], 1u);
      const unsigned tg = og / nx;
      if (og + 1u == (tg + 1u) * nx) xb_add(&bar[XB_TOPGEN], 1u);
      else XB_SPIN(xb_ld(&bar[XB_TOPGEN]) == tg, bar);
      __builtin_amdgcn_fence(__ATOMIC_ACQUIRE, "agent");
      xb_add(&bar[XB_XGEN(b.x)], 1u);
      asm volatile("s_waitcnt vmcnt(0)" ::: "memory");
    } else {
      XB_SPIN(xb_ld(&bar[XB_XGEN(b.x)]) == gen, bar);
      __builtin_amdgcn_fence(__ATOMIC_ACQUIRE, "agent");
      asm volatile("s_waitcnt vmcnt(0)" ::: "memory");
    }
  }
  __syncthreads();
}

#if MEGA
__global__ void __launch_bounds__(256, 2) fwd_megakernel(Params P) {
  __shared__ __attribute__((aligned(16))) char smem[SMEM_BYTES];
  __shared__ uint4 xb_words;
  cg::grid_group grid = cg::this_grid();
  if (P.ws == nullptr) grid.sync();
  if (threadIdx.x == 0) xb_words = make_uint4(0u, 0u, 0u, 0u);
  __syncthreads();
  const XcdBarrier xb = xcd_barrier_post((unsigned*)(P.ws + OFF_BAR), (volatile LAS unsigned*)&xb_words);
  const int bid = blockIdx.x, nb = gridDim.x;
  phase0(P, bid, nb, smem); xcd_barrier(xb);
  phase1(P, bid, nb, smem); xcd_barrier(xb);
  phase2(P, bid, nb, smem); xcd_barrier(xb);
  phase3(P, bid, nb, smem); xcd_barrier(xb);
  phase4(P, smem); xcd_barrier(xb);
  phase5(P, bid, nb, smem); xcd_barrier(xb);
  phase6(P, bid, nb, smem); xcd_barrier(xb);
  phase7(P, bid, nb, smem);
}
#else
#define PHASE_KERNEL(NAME, CALL)                                             \
  __global__ void __launch_bounds__(256, 2) NAME(Params P) {                 \
    __shared__ __attribute__((aligned(16))) char smem[SMEM_BYTES];           \
    const int bid = blockIdx.x, nb = gridDim.x; (void)bid; (void)nb;         \
    CALL;                                                                    \
  }
PHASE_KERNEL(k_p0, phase0(P, bid, nb, smem))
PHASE_KERNEL(k_p1, phase1(P, bid, nb, smem))
PHASE_KERNEL(k_p2, phase2(P, bid, nb, smem))
PHASE_KERNEL(k_p3, phase3(P, bid, nb, smem))
PHASE_KERNEL(k_p4, phase4(P, smem))
PHASE_KERNEL(k_p5, phase5(P, bid, nb, smem))
PHASE_KERNEL(k_p6, phase6(P, bid, nb, smem))
PHASE_KERNEL(k_p7, phase7(P, bid, nb, smem))
#endif

extern "C" void kernel_launch(void* const* d_in, const int* in_sizes, int n_in, void* d_out, int out_size, void* d_ws,
                              size_t ws_size, hipStream_t stream) {
  Params p{};
  p.x = (const float*)d_in[0]; p.mem = (const float*)d_in[1]; p.pos = (const int*)d_in[2];
  p.norm_mix = (const float*)d_in[3]; p.norm_mem = (const float*)d_in[4]; p.w_in = (const float*)d_in[5];
  p.q_a_norm = (const float*)d_in[6]; p.w_uq = (const float*)d_in[7]; p.kv_a_norm = (const float*)d_in[8];
  p.w_ukv = (const float*)d_in[9]; p.mla_q_norm = (const float*)d_in[10]; p.mla_k_norm = (const float*)d_in[11];
  p.lb_logits = (const float*)d_in[12]; p.hg_out_norm = (const float*)d_in[13]; p.w_mem_kv = (const float*)d_in[14];
  p.mem_q_norm = (const float*)d_in[15]; p.mem_k_norm = (const float*)d_in[16]; p.mla_out_norm = (const float*)d_in[17];
  p.mem_out_norm = (const float*)d_in[18]; p.w_out = (const float*)d_in[19]; p.norm_ffn = (const float*)d_in[20];
  p.w_gate = (const float*)d_in[21]; p.w_up = (const float*)d_in[22]; p.w_down = (const float*)d_in[23];
  p.out = (float*)d_out; p.ws = (char*)d_ws;
  for (int i = 0; i < 32; ++i) p.inv_freq[i] = std::pow(10000.0, -(double)i / 32.0);
#if MEGA
  static int grid_blocks = 0;
  if (!grid_blocks) {
    int dev = 0, cus = 0, per_cu = 0;
    hipGetDevice(&dev);
    hipDeviceGetAttribute(&cus, hipDeviceAttributeMultiprocessorCount, dev);
    hipOccupancyMaxActiveBlocksPerMultiprocessor(&per_cu, fwd_megakernel, 256, 0);
    if (per_cu > 2) per_cu = 2;
    if (per_cu < 1) per_cu = 1;
    grid_blocks = cus * per_cu;
  }
  void* args[] = {&p};
  (void)hipMemsetAsync((char*)d_ws + OFF_BAR, 0, XCD_BAR_WORDS * sizeof(unsigned), stream);
  hipError_t e = hipLaunchCooperativeKernel((void*)fwd_megakernel, dim3(grid_blocks), dim3(256), args, 0, stream);
  if (e != hipSuccess) fprintf(stderr, "cooperative launch failed: %s (grid %d)\n", hipGetErrorString(e), grid_blocks);
#else
  const int G = 512;
  k_p0<<<G, 256, 0, stream>>>(p);
  k_p1<<<G, 256, 0, stream>>>(p);
  k_p2<<<G, 256, 0, stream>>>(p);
  k_p3<<<G, 256, 0, stream>>>(p);
  k_p4<<<G, 256, 0, stream>>>(p);
  k_p5<<<G, 256, 0, stream>>>(p);
  k_p6<<<G, 256, 0, stream>>>(p);
  k_p7<<<G, 256, 0, stream>>>(p);
#endif
}
```
